# Optimizing an MI355X kernel written in HIP

```python
import math
import jax, jax.numpy as jnp
from jax import lax
import numpy as np

D_MODEL = 1024
BATCH = 8
SEQ = 2048
DEPTH = 1
DEC_BATCH = 16
DEC_SEQ = 64
PAST_LEN = 4096

CHUNK = 64
D_MIX = D_MODEL
D_SSM = D_MIX // 2
SSM_GROUP = 16
N_SSM_GROUPS = D_SSM // SSM_GROUP
SSM_STATE = 64
D_ATT = D_MIX - D_SSM
N_HEADS = 4
HEAD_DIM = D_ATT // (2 * N_HEADS)
V_DIM = 2 * HEAD_DIM
D_IN = D_SSM + 3 * D_ATT
N_MEM = 256
N_MEM_HEADS = 4
MEM_HEAD_DIM = D_MODEL // N_MEM_HEADS
D_FF = 2816
Q_BLOCK = 128
EPS = 1e-6

kernel_name = "hymba_s5_diffattn_streaming_step"

F32 = jnp.float32


def rmsnorm(x, g):
    xf = x.astype(F32)
    y = xf * lax.rsqrt(jnp.mean(xf * xf, axis=-1, keepdims=True) + EPS)
    return (y * g.astype(F32)).astype(x.dtype)


def swiglu(x, w_gu, w_d):
    gate, up = jnp.split(x @ w_gu, 2, axis=-1)
    return (jax.nn.silu(gate) * up) @ w_d


def ffn_half(x, g, w_gu, w_d):
    return x + 0.5 * swiglu(rmsnorm(x, g), w_gu, w_d)


def mix_inputs(h, g_mix, w_in):
    z = rmsnorm(h, g_mix) @ w_in
    bsz, L, _ = z.shape
    u = z[..., :D_SSM]
    q = z[..., D_SSM:D_SSM + D_ATT].reshape(bsz, L, N_HEADS, 2, HEAD_DIM)
    k = z[..., D_SSM + D_ATT:D_SSM + 2 * D_ATT].reshape(bsz, L, N_HEADS, 2 * HEAD_DIM)
    v = z[..., D_SSM + 2 * D_ATT:].reshape(bsz, L, N_HEADS, V_DIM)
    return u, q, k, v


def s5_mixer(u, h0_re, h0_im, a_re, a_im, log_dt, b_re, b_im, c_re, c_im, d_skip, w_glu, b_glu):
    bsz, L, _ = u.shape
    lam = lax.complex(a_re.astype(F32), a_im.astype(F32))
    dt = jnp.exp(log_dt.astype(F32))[:, None]
    a_bar = jnp.exp(lam * dt)
    b = lax.complex(b_re.astype(F32), b_im.astype(F32))
    b_bar = ((a_bar - 1.0) / lam)[..., None] * b
    ug = u.astype(F32).reshape(bsz, L, N_SSM_GROUPS, SSM_GROUP)
    bu = jnp.einsum('gph,blgh->blgp', b_bar, ug)
    h0 = lax.complex(h0_re.astype(F32), h0_im.astype(F32))
    bu = bu.at[:, 0].add(a_bar * h0)
    a_seq = jnp.broadcast_to(a_bar, bu.shape)

    def combine(left, right):
        a_l, b_l = left
        a_r, b_r = right
        return a_r * a_l, a_r * b_l + b_r

    _, hs = lax.associative_scan(combine, (a_seq, bu), axis=1)
    c = lax.complex(c_re.astype(F32), c_im.astype(F32))
    y = jnp.einsum('ghp,blgp->blgh', c, hs).real + d_skip.astype(F32).reshape(N_SSM_GROUPS, SSM_GROUP) * ug
    y = jax.nn.gelu(y.reshape(bsz, L, D_SSM))
    y = y * jax.nn.sigmoid(y @ w_glu.astype(F32) + b_glu.astype(F32))
    h_last = hs[:, -1]
    return y.astype(u.dtype), h_last.real, h_last.imag


def alibi_slopes():
    return 2.0 ** (-8.0 * jnp.arange(1, N_HEADS + 1, dtype=F32) / N_HEADS)


def diff_lambda(lq, lk, lam_init):
    lq = lq.astype(F32)
    lk = lk.astype(F32)
    return jnp.exp(jnp.sum(lq[0] * lk[0])) - jnp.exp(jnp.sum(lq[1] * lk[1])) + lam_init


def diff_attend(q, k, v, qpos, kpos, lam, mask):
    kk = k.reshape(k.shape[:3] + (2, HEAD_DIM))
    s = jnp.einsum('bqhme,bkhme->bhmqk', q.astype(F32), kk.astype(F32)) * (HEAD_DIM ** -0.5)
    dist = jnp.abs(qpos[:, None] - kpos[None, :]).astype(F32)
    s = s - alibi_slopes()[None, :, None, None, None] * dist
    if mask is not None:
        s = jnp.where(mask, s, -jnp.inf)
    p = jax.nn.softmax(s, axis=-1)
    w = p[:, :, 0] - lam * p[:, :, 1]
    return jnp.einsum('bhqk,bkhv->bqhv', w, v.astype(F32))


def subln(o, g_subln, lam_init):
    return rmsnorm(o, g_subln) * (1.0 - lam_init)


def diff_attn_prompt(q, k, v, lam, lam_init, g_subln):
    bsz, L = q.shape[:2]
    nblk = L // Q_BLOCK
    kpos = jnp.arange(L)
    qb = q.reshape(bsz, nblk, Q_BLOCK, N_HEADS, 2, HEAD_DIM).swapaxes(0, 1)

    def block(args):
        qi, i = args
        qpos = i * Q_BLOCK + jnp.arange(Q_BLOCK)
        mask = (kpos[None, :] // CHUNK) <= (qpos[:, None] // CHUNK)
        return diff_attend(qi, k, v, qpos, kpos, lam, mask)

    o = lax.map(block, (qb, jnp.arange(nblk)))
    o = o.swapaxes(0, 1).reshape(bsz, L, N_HEADS, V_DIM)
    return subln(o, g_subln, lam_init)


def diff_attn_sample(q, k_new, v_new, k_cache, v_cache, lam, lam_init, g_subln):
    past = k_cache.shape[1]
    n_new = q.shape[1]
    k_all = jnp.concatenate([k_cache, k_new.astype(k_cache.dtype)], axis=1)
    v_all = jnp.concatenate([v_cache, v_new.astype(v_cache.dtype)], axis=1)
    qpos = past + jnp.arange(n_new)
    kpos = jnp.arange(past + n_new)
    o = diff_attend(q, k_all, v_all, qpos, kpos, lam, None)
    return subln(o, g_subln, lam_init)


def merge_groups(y_ssm, y_att, w_out):
    bsz, L = y_ssm.shape[:2]
    cat = jnp.concatenate([y_ssm, y_att.reshape(bsz, L, D_ATT).astype(y_ssm.dtype)], axis=-1)
    return cat @ w_out


def mem_kv(mem, g_mem, w_ck, w_cv):
    bsz = mem.shape[0]
    m = rmsnorm(mem, g_mem)
    mk = (m @ w_ck).reshape(bsz, N_MEM, N_MEM_HEADS, MEM_HEAD_DIM)
    mv = (m @ w_cv).reshape(bsz, N_MEM, N_MEM_HEADS, MEM_HEAD_DIM)
    return mk, mv


def cross_attend(h, g_cross, w_cq, w_co, mk, mv):
    bsz, L, _ = h.shape
    q = (rmsnorm(h, g_cross) @ w_cq).reshape(bsz, L, N_MEM_HEADS, MEM_HEAD_DIM)
    s = jnp.einsum('bqhd,bkhd->bhqk', q.astype(F32), mk.astype(F32)) * (MEM_HEAD_DIM ** -0.5)
    p = jax.nn.softmax(s, axis=-1)
    o = jnp.einsum('bhqk,bkhd->bqhd', p, mv.astype(F32)).reshape(bsz, L, D_MODEL)
    return o.astype(h.dtype) @ w_co


def setup_inputs(seed: int = 0) -> dict:
    key = jax.random.key(seed)
    keys = iter(jax.random.split(key, 48))

    def nrm(shape, scale=1.0):
        return scale * jax.random.normal(next(keys), shape, F32)

    def gain(shape):
        return 1.0 + nrm(shape, 0.02)

    G, P, H = N_SSM_GROUPS, SSM_STATE, SSM_GROUP
    n_idx = jnp.arange(P, dtype=F32)
    inp = {}
    inp["x_prompt"] = nrm((BATCH, SEQ, D_MODEL))
    inp["x_sample"] = nrm((DEC_BATCH, DEC_SEQ, D_MODEL))
    inp["cache_attn_k"] = nrm((DEPTH, DEC_BATCH, PAST_LEN, N_HEADS, 2 * HEAD_DIM))
    inp["cache_attn_v"] = nrm((DEPTH, DEC_BATCH, PAST_LEN, N_HEADS, V_DIM))
    inp["state_s5_re"] = nrm((DEPTH, DEC_BATCH, G, P), 0.5)
    inp["state_s5_im"] = nrm((DEPTH, DEC_BATCH, G, P), 0.5)
    inp["cache_mem_k"] = nrm((DEPTH, DEC_BATCH, N_MEM, N_MEM_HEADS, MEM_HEAD_DIM))
    inp["cache_mem_v"] = nrm((DEPTH, DEC_BATCH, N_MEM, N_MEM_HEADS, MEM_HEAD_DIM))
    inp["mem_prompt"] = nrm((BATCH, N_MEM, D_MODEL))
    inp["g_ffn1"] = gain((DEPTH, D_MODEL))
    inp["w_ffn1_gu"] = nrm((DEPTH, D_MODEL, 2 * D_FF), D_MODEL ** -0.5)
    inp["w_ffn1_d"] = nrm((DEPTH, D_FF, D_MODEL), D_FF ** -0.5)
    inp["g_mix"] = gain((DEPTH, D_MODEL))
    inp["w_in"] = nrm((DEPTH, D_MODEL, D_IN), D_MODEL ** -0.5)
    inp["ssm_a_re"] = -0.5 + nrm((DEPTH, G, P), 0.01)
    inp["ssm_a_im"] = math.pi * n_idx + nrm((DEPTH, G, P), 0.01)
    inp["ssm_log_dt"] = jax.random.uniform(next(keys), (DEPTH, G), F32, math.log(1e-3), math.log(1e-1))
    inp["ssm_b_re"] = nrm((DEPTH, G, P, H), (2 * H) ** -0.5)
    inp["ssm_b_im"] = nrm((DEPTH, G, P, H), (2 * H) ** -0.5)
    inp["ssm_c_re"] = nrm((DEPTH, G, H, P), (2 * P) ** -0.5)
    inp["ssm_c_im"] = nrm((DEPTH, G, H, P), (2 * P) ** -0.5)
    inp["ssm_d"] = nrm((DEPTH, D_SSM))
    inp["w_glu"] = nrm((DEPTH, D_SSM, D_SSM), D_SSM ** -0.5)
    inp["b_glu"] = nrm((DEPTH, D_SSM), 0.01)
    inp["lambda_q"] = nrm((DEPTH, 2, HEAD_DIM), 0.1)
    inp["lambda_k"] = nrm((DEPTH, 2, HEAD_DIM), 0.1)
    inp["g_subln"] = gain((DEPTH, V_DIM))
    inp["w_out"] = nrm((DEPTH, D_MIX, D_MODEL), D_MIX ** -0.5)
    inp["g_mem"] = gain((DEPTH, D_MODEL))
    inp["g_cross"] = gain((DEPTH, D_MODEL))
    inp["w_cq"] = nrm((DEPTH, D_MODEL, D_MODEL), D_MODEL ** -0.5)
    inp["w_ck"] = nrm((DEPTH, D_MODEL, D_MODEL), D_MODEL ** -0.5)
    inp["w_cv"] = nrm((DEPTH, D_MODEL, D_MODEL), D_MODEL ** -0.5)
    inp["w_co"] = nrm((DEPTH, D_MODEL, D_MODEL), D_MODEL ** -0.5)
    inp["g_ffn2"] = gain((DEPTH, D_MODEL))
    inp["w_ffn2_gu"] = nrm((DEPTH, D_MODEL, 2 * D_FF), D_MODEL ** -0.5)
    inp["w_ffn2_d"] = nrm((DEPTH, D_FF, D_MODEL), D_FF ** -0.5)
    inp["g_final"] = gain((D_MODEL,))
    return inp


def reference(x_prompt, x_sample, cache_attn_k, cache_attn_v, state_s5_re, state_s5_im,
              cache_mem_k, cache_mem_v, mem_prompt,
              g_ffn1, w_ffn1_gu, w_ffn1_d, g_mix, w_in,
              ssm_a_re, ssm_a_im, ssm_log_dt, ssm_b_re, ssm_b_im, ssm_c_re, ssm_c_im, ssm_d,
              w_glu, b_glu, lambda_q, lambda_k, g_subln, w_out,
              g_mem, g_cross, w_cq, w_ck, w_cv, w_co,
              g_ffn2, w_ffn2_gu, w_ffn2_d, g_final):
    xp, xs = x_prompt, x_sample
    kp_l, vp_l, rep_l, imp_l, mkp_l, mvp_l = [], [], [], [], [], []
    ks_l, vs_l, res_l, ims_l = [], [], [], []
    for l in range(DEPTH):
        lam_init = 0.8 - 0.6 * math.exp(-0.3 * l)
        lam = diff_lambda(lambda_q[l], lambda_k[l], lam_init)
        ssm = (ssm_a_re[l], ssm_a_im[l], ssm_log_dt[l], ssm_b_re[l], ssm_b_im[l],
               ssm_c_re[l], ssm_c_im[l], ssm_d[l], w_glu[l], b_glu[l])

        hp = ffn_half(xp, g_ffn1[l], w_ffn1_gu[l], w_ffn1_d[l])
        up, qp, kp, vp = mix_inputs(hp, g_mix[l], w_in[l])
        zero_state = jnp.zeros((xp.shape[0], N_SSM_GROUPS, SSM_STATE), F32)
        yp_ssm, rep, imp = s5_mixer(up, zero_state, zero_state, *ssm)
        yp_att = diff_attn_prompt(qp, kp, vp, lam, lam_init, g_subln[l])
        hp = hp + merge_groups(yp_ssm, yp_att, w_out[l])
        mkp, mvp = mem_kv(mem_prompt, g_mem[l], w_ck[l], w_cv[l])
        hp = hp + cross_attend(hp, g_cross[l], w_cq[l], w_co[l], mkp, mvp)
        xp = ffn_half(hp, g_ffn2[l], w_ffn2_gu[l], w_ffn2_d[l])

        hs = ffn_half(xs, g_ffn1[l], w_ffn1_gu[l], w_ffn1_d[l])
        us, qs, ks, vs = mix_inputs(hs, g_mix[l], w_in[l])
        ys_ssm, res, ims = s5_mixer(us, state_s5_re[l], state_s5_im[l], *ssm)
        ys_att = diff_attn_sample(qs, ks, vs, cache_attn_k[l], cache_attn_v[l], lam, lam_init, g_subln[l])
        hs = hs + merge_groups(ys_ssm, ys_att, w_out[l])
        hs = hs + cross_attend(hs, g_cross[l], w_cq[l], w_co[l], cache_mem_k[l], cache_mem_v[l])
        xs = ffn_half(hs, g_ffn2[l], w_ffn2_gu[l], w_ffn2_d[l])

        kp_l.append(kp); vp_l.append(vp); rep_l.append(rep); imp_l.append(imp)
        mkp_l.append(mkp); mvp_l.append(mvp)
        ks_l.append(ks); vs_l.append(vs); res_l.append(res); ims_l.append(ims)

    y_prompt = rmsnorm(xp, g_final)
    y_sample = rmsnorm(xs, g_final)
    return (y_prompt, y_sample,
            jnp.stack(kp_l), jnp.stack(vp_l), jnp.stack(rep_l), jnp.stack(imp_l),
            jnp.stack(mkp_l), jnp.stack(mvp_l),
            jnp.stack(ks_l), jnp.stack(vs_l), jnp.stack(res_l), jnp.stack(ims_l))
```

```cpp
#include <hip/hip_runtime.h>
#include <hip/hip_cooperative_groups.h>
#include <cstdio>
#include <cstdint>
#include <cmath>
namespace cg = cooperative_groups;
namespace pg8 {
#define PG8_LAS __attribute__((address_space(3)))
typedef unsigned short bf16_t;
typedef short bf16x8 __attribute__((ext_vector_type(8)));
typedef float f32x4 __attribute__((ext_vector_type(4)));
typedef unsigned u32x4 __attribute__((ext_vector_type(4)));
constexpr int BM = 256, BK = 64, HALF = 128, HTB = HALF * BK * 2  , STAGE_BYTES = 8 * HTB, NXCD = 8, WGM = 8;

__host__ __device__ __forceinline__ int lds_byte(int r, int c) { const int st = (r >> 4) * 2 + (c >> 5), rr = r & 15, cc = c & 31, ob = rr * 64 + cc * 2; return st * 1024 + (ob ^ (((ob >> 9) & 1) << 5)); }
__host__ __device__ __forceinline__ void stage_rc(int b, int& R, int& C) { const int st = b / 1024, sb = b % 1024, swz = sb ^ (((sb >> 9) & 1) << 5); R = (st >> 1) * 16 + swz / 64; C = (st & 1) * 32 + (swz % 64) / 2; }
__host__ __device__ __forceinline__ int perm32(int rho) { const int n = rho >> 4, i = rho & 15; return 8 * (i >> 2) + 4 * n + (i & 3); }

struct Unit { int pm, pn; };
struct Gemm { const bf16_t* A; const bf16_t* Bt; int M, N, K; };

struct StaticOrder {
    int nM, nN, nwg, G, c;
    __host__ __device__ void init(int M, int N, int G_, int c_) { nM = M / BM; nN = N / BM; nwg = nM * nN; G = G_; c = c_; }
    __host__ __device__ __forceinline__ bool next(int i, Unit& u) const {
        const long L = (long)i * G + c; if (L >= nwg) return false;
        int wgid = (int)L; { const int q = nwg / NXCD, r = nwg % NXCD, xcd = wgid % NXCD, off = wgid / NXCD; wgid = (xcd < r ? xcd * (q + 1) : r * (q + 1) + (xcd - r) * q) + off; }
        const int nig = WGM * nN, gid = wgid / nig, fm = gid * WGM, gsz = (nM - fm) < WGM ? (nM - fm) : WGM;
        u.pm = fm + ((wgid % nig) % gsz); u.pn = (wgid % nig) / gsz; return true;
    }
    __device__ __forceinline__ void a_ready(const Unit&) const {}
    __device__ __forceinline__ void done(const Unit&) const {}
};

__device__ __forceinline__ unsigned cvt_pk_bf16(float lo, float hi) { unsigned r; asm volatile("v_cvt_pk_bf16_f32 %0, %1, %2" : "=v"(r) : "v"(lo), "v"(hi)); return r; }
template <class Epi, class Sched, bool ALIGN_EPI = false, bool SP2 = false>
__device__ __forceinline__ void gemm_phase(PG8_LAS unsigned char* lds, const Gemm g, const Sched& S, const Epi& E) {
    const int tid = threadIdx.x, wid = __builtin_amdgcn_readfirstlane(tid >> 6), lane = tid & 63, wr = wid >> 2, wc = wid & 3, fr = lane & 15, fq = lane >> 4;
    const int K = g.K, nt = K / BK;
    unsigned voffA[2], voffB[2];
#pragma unroll
    for (int i = 0; i < 2; ++i) { int R, C; stage_rc(tid * 16 + i * 8192, R, C); const int Rb = Epi::PERM ? ((R & ~31) + perm32(R & 31)) : R;
        voffA[i] = (unsigned)(R * K + C) * 2u; voffB[i] = (unsigned)(Rb * K + C) * 2u; }
    const size_t kstep = (size_t)(BK * 2);
    const size_t hstep = (size_t)HALF * K * 2;
    const size_t tstep = 2 * hstep;
    const unsigned ldsw = (unsigned)wid * 1024u;
    const int aoff = lds_byte(wr * 64 + fr, fq * 8), boff = lds_byte(wc * 32 + fr, fq * 8);
#define PG8_SA(b, h) (((b) * 2 + (h)) * HTB)
#define PG8_SB(b, h) ((4 + (b) * 2 + (h)) * HTB)
#define PG8_STAGE(bufoff, gbase, voff) do { _Pragma("unroll") for (int _i = 0; _i < 2; ++_i) \
        __builtin_amdgcn_global_load_lds((const unsigned*)((const char*)(gbase) + (voff)[_i]), (PG8_LAS unsigned*)(lds + (bufoff) + ldsw + _i * 8192), 16, 0, 0); } while (0)
#define PG8_LDA(dst, b, h) do { _Pragma("unroll") for (int m = 0; m < 4; ++m) _Pragma("unroll") for (int k = 0; k < 2; ++k) dst[m][k] = *(const PG8_LAS bf16x8*)(lds + PG8_SA(b, h) + aoff + m * 2048 + k * 1024); } while (0)
#define PG8_LDB(dst, b, h) do { _Pragma("unroll") for (int n = 0; n < 2; ++n) _Pragma("unroll") for (int k = 0; k < 2; ++k) dst[n][k] = *(const PG8_LAS bf16x8*)(lds + PG8_SB(b, h) + boff + n * 2048 + k * 1024); } while (0)
#define PG8_MMA(ai, bj, At, Bt) do { __builtin_amdgcn_s_setprio(1); _Pragma("unroll") for (int m = 0; m < 4; ++m) _Pragma("unroll") for (int n = 0; n < 2; ++n) _Pragma("unroll") for (int k = 0; k < 2; ++k) \
        acc[ai][bj][m][n] = __builtin_amdgcn_mfma_f32_16x16x32_bf16(Bt[n][k], At[m][k], acc[ai][bj][m][n], 0, 0, 0); __builtin_amdgcn_s_setprio(0); } while (0)
#define PG8_WAIT_V(n) asm volatile("s_waitcnt vmcnt(" #n ")" ::: "memory")
#define PG8_WAIT_L(n) asm volatile("s_waitcnt lgkmcnt(" #n ")" ::: "memory")
#define PG8_BAR __builtin_amdgcn_s_barrier()
#define PG8_SCHED __builtin_amdgcn_sched_barrier(0)
    Unit cur, nxt; int ui = 0;
    if (!S.next(0, cur)) return;
    f32x4 acc[2][2][4][2];
#pragma unroll
    for (int a = 0; a < 2; ++a)
#pragma unroll
        for (int b = 0; b < 2; ++b)
#pragma unroll
            for (int m = 0; m < 4; ++m)
#pragma unroll
                for (int n = 0; n < 2; ++n) acc[a][b][m][n] = (f32x4){0.f, 0.f, 0.f, 0.f};
    bf16x8 At[4][2], B0[2][2], B1[2][2];
    const char* cA = (const char*)g.A + (size_t)cur.pm * tstep; const char* cB = (const char*)g.Bt + (size_t)cur.pn * tstep;
    S.a_ready(cur);
    if constexpr (SP2) {
        PG8_STAGE(PG8_SB(0, 0), cB, voffB); PG8_STAGE(PG8_SB(0, 1), cB + hstep, voffB); PG8_STAGE(PG8_SA(0, 0), cA, voffA); PG8_STAGE(PG8_SA(0, 1), cA + hstep, voffA);
        if (wr == 1) PG8_BAR;
        PG8_WAIT_V(2); PG8_BAR;
        PG8_STAGE(PG8_SB(1, 0), cB + kstep, voffB); PG8_STAGE(PG8_SA(1, 0), cA + kstep, voffA); PG8_STAGE(PG8_SB(1, 1), cB + hstep + kstep, voffB);
        PG8_WAIT_V(6); PG8_BAR;
    } else {
        PG8_STAGE(PG8_SB(0, 0), cB, voffB); PG8_STAGE(PG8_SA(0, 0), cA, voffA); PG8_STAGE(PG8_SB(0, 1), cB + hstep, voffB); PG8_STAGE(PG8_SA(0, 1), cA + hstep, voffA);
        if (wr == 1) PG8_BAR;
        PG8_WAIT_V(4); PG8_BAR;
        PG8_STAGE(PG8_SB(1, 0), cB + kstep, voffB); PG8_STAGE(PG8_SA(1, 0), cA + kstep, voffA); PG8_STAGE(PG8_SB(1, 1), cB + hstep + kstep, voffB);
        PG8_WAIT_V(6); PG8_BAR;
    }
    for (;;) {
        const bool has_next = S.next(ui + 1, nxt);
        const char* nA = has_next ? (const char*)g.A + (size_t)nxt.pm * tstep : cA; const char* nB = has_next ? (const char*)g.Bt + (size_t)nxt.pn * tstep : cB;
        for (int t = 0; t < nt; t += 2) {
            const bool last = (t == nt - 2);
            const char* a1 = cA + (size_t)(t + 1) * kstep;
            const char* a2 = last ? nA : cA + (size_t)(t + 2) * kstep; const char* b2 = last ? nB : cB + (size_t)(t + 2) * kstep;
            const char* a3 = a2 + kstep; const char* b3 = b2 + kstep;
            if (last && has_next) S.a_ready(nxt);
            if constexpr (SP2) {
            PG8_LDB(B0, 0, 0); PG8_LDB(B1, 0, 1); PG8_SCHED; PG8_LDA(At, 0, 0); PG8_STAGE(PG8_SA(1, 1), a1 + hstep, voffA);
            PG8_WAIT_V(8); PG8_WAIT_L(0); PG8_BAR; PG8_MMA(0, 0, At, B0); PG8_MMA(0, 1, At, B1); PG8_BAR; PG8_SCHED;
            PG8_LDA(At, 0, 1); PG8_STAGE(PG8_SB(0, 0), b2, voffB); PG8_STAGE(PG8_SB(0, 1), b2 + hstep, voffB); PG8_STAGE(PG8_SA(0, 0), a2, voffA);
            PG8_WAIT_V(8); PG8_WAIT_L(0); PG8_BAR; PG8_MMA(1, 0, At, B0); PG8_MMA(1, 1, At, B1); PG8_BAR; PG8_SCHED;
            PG8_LDB(B0, 1, 0); PG8_LDB(B1, 1, 1); PG8_SCHED; PG8_LDA(At, 1, 0); PG8_STAGE(PG8_SA(0, 1), a2 + hstep, voffA);
            PG8_WAIT_V(8); PG8_WAIT_L(0); PG8_BAR; PG8_MMA(0, 0, At, B0); PG8_MMA(0, 1, At, B1); PG8_BAR; PG8_SCHED;
            PG8_LDA(At, 1, 1); PG8_STAGE(PG8_SB(1, 0), b3, voffB); PG8_STAGE(PG8_SB(1, 1), b3 + hstep, voffB); PG8_STAGE(PG8_SA(1, 0), a3, voffA);
            PG8_WAIT_V(8); PG8_WAIT_L(0); PG8_BAR; PG8_MMA(1, 0, At, B0); PG8_MMA(1, 1, At, B1); PG8_BAR; PG8_SCHED;
            } else {
            PG8_LDB(B0, 0, 0); PG8_SCHED; PG8_LDA(At, 0, 0); PG8_STAGE(PG8_SA(1, 1), a1 + hstep, voffA);
            PG8_WAIT_L(8); PG8_BAR; PG8_WAIT_L(0); PG8_MMA(0, 0, At, B0); PG8_BAR; PG8_SCHED;
            PG8_LDB(B1, 0, 1); PG8_STAGE(PG8_SB(0, 0), b2, voffB);
            PG8_BAR; PG8_WAIT_L(0); PG8_MMA(0, 1, At, B1); PG8_BAR;
            PG8_LDA(At, 0, 1); PG8_STAGE(PG8_SA(0, 0), a2, voffA);
            PG8_BAR; PG8_WAIT_L(0); PG8_MMA(1, 0, At, B0); PG8_BAR; PG8_SCHED;
            PG8_STAGE(PG8_SB(0, 1), b2 + hstep, voffB);
            PG8_WAIT_V(6); PG8_BAR; PG8_MMA(1, 1, At, B1); PG8_BAR;
            PG8_LDB(B0, 1, 0); PG8_SCHED; PG8_LDA(At, 1, 0); PG8_STAGE(PG8_SA(0, 1), a2 + hstep, voffA);
            PG8_WAIT_L(8); PG8_BAR; PG8_WAIT_L(0); PG8_MMA(0, 0, At, B0); PG8_BAR; PG8_SCHED;
            PG8_LDB(B1, 1, 1); PG8_STAGE(PG8_SB(1, 0), b3, voffB);
            PG8_BAR; PG8_WAIT_L(0); PG8_MMA(0, 1, At, B1); PG8_BAR;
            PG8_LDA(At, 1, 1); PG8_STAGE(PG8_SA(1, 0), a3, voffA);
            PG8_BAR; PG8_WAIT_L(0); PG8_MMA(1, 0, At, B0); PG8_BAR; PG8_SCHED;
            PG8_STAGE(PG8_SB(1, 1), b3 + hstep, voffB);
            PG8_WAIT_V(6); PG8_BAR; PG8_MMA(1, 1, At, B1); PG8_BAR;
            }
        }
        if constexpr (ALIGN_EPI) { if (wr == 0) PG8_BAR; }
        if constexpr (!Epi::AFTER_DRAIN) { E(acc, cur, wr, wc, fr, fq, ui); S.done(cur); }
        if (!has_next) break;
#pragma unroll
        for (int a = 0; a < 2; ++a)
#pragma unroll
            for (int b = 0; b < 2; ++b)
#pragma unroll
                for (int m = 0; m < 4; ++m)
#pragma unroll
                    for (int n = 0; n < 2; ++n) acc[a][b][m][n] = (f32x4){0.f, 0.f, 0.f, 0.f};
        cur = nxt; cA = nA; cB = nB; ++ui;
        if constexpr (ALIGN_EPI) { if (wr == 1) PG8_BAR; }
    }
    PG8_WAIT_V(0);
    if constexpr (!ALIGN_EPI) { if (wr == 0) PG8_BAR; }
    PG8_BAR;
    if constexpr (Epi::AFTER_DRAIN) { E.fused(acc, cur, wr, wc, fr, fq, lds, wid, lane); S.done(cur); }
#undef PG8_SA
#undef PG8_SB
#undef PG8_STAGE
#undef PG8_LDA
#undef PG8_LDB
#undef PG8_MMA
#undef PG8_WAIT_V
#undef PG8_WAIT_L
#undef PG8_BAR
#undef PG8_SCHED
}
}

#define LAS __attribute__((address_space(3)))
typedef unsigned short bf16_t;
typedef short bf16x8 __attribute__((ext_vector_type(8)));
typedef short s16x4 __attribute__((ext_vector_type(4)));
typedef float f32x4 __attribute__((ext_vector_type(4)));
typedef float f32x2 __attribute__((ext_vector_type(2)));
typedef unsigned u32x4 __attribute__((ext_vector_type(4)));
typedef unsigned u32x2 __attribute__((ext_vector_type(2)));
typedef __bf16 bf16x2_t __attribute__((ext_vector_type(2)));

constexpr int MP = 16384, MS = 1024, MT = MP + MS;
constexpr int DM = 1024, DFF = 2816, SEQ = 2048, PAST = 4096;
constexpr float EPS = 1e-6f;
constexpr float LOG2E = 1.4426950408889634f;
constexpr float QS_DIFF = 0.125f * LOG2E, QS_CROSS = 0.0625f * LOG2E;
constexpr float LAM_INIT = 0.2f;

constexpr size_t O_Y = 0, O_KP = 17825792, O_VP = 26214400, O_REP = 34603008, O_IMP = 34619392, O_MKP = 34635776, O_MVP = 36732928,
                 O_KS = 38830080, O_VS = 39354368, O_RES = 39878656, O_IMS = 39911424, O_TOTAL = 39944192;
constexpr size_t MiB = 1u << 20;
constexpr size_t W_SS = 0;
constexpr size_t W_SSM = 348160, W_ABAR = 356352, W_BBAR = 372736, W_LAM = 634880;
constexpr size_t W_GU1 = 1 * MiB, W_D1 = 12 * MiB, W_IN = 18 * MiB, W_GLU = 22 * MiB, W_OUT = 23 * MiB, W_CQ = 25 * MiB, W_CKV = 27 * MiB, W_CO = 31 * MiB,
                 W_GU2 = 33 * MiB, W_D2 = 44 * MiB;
constexpr size_t W_RB = 50 * MiB, W_R = 84 * MiB, W_H = 152 * MiB, W_QC = 152 * MiB, W_OC = 186 * MiB, W_U = 246 * MiB, W_QB = 280 * MiB, W_KB = 297 * MiB,
                 W_VB = 314 * MiB, W_YACT = 331 * MiB, W_CAT = 348 * MiB, W_MEMB = 382 * MiB, W_MK = 386 * MiB, W_MV = 398 * MiB, W_PART = 410 * MiB,
                 W_ML = 426 * MiB, W_SSP = 427 * MiB, W_END = 434 * MiB;
constexpr size_t W_BAR = 655360;
constexpr int LDS_BYTES = 147456;

struct Args { const float* in[38]; float* out; unsigned char* ws; int lo, hi; };

__device__ __forceinline__ unsigned pk2(float lo, float hi) { f32x2 v = {lo, hi}; bf16x2_t b = __builtin_convertvector(v, bf16x2_t); return __builtin_bit_cast(unsigned, b); }
__device__ __forceinline__ float bf2f(bf16_t v) { return __builtin_bit_cast(float, (unsigned)v << 16); }
__device__ __forceinline__ float wave_sum(float v) {
#pragma unroll
    for (int o = 1; o < 64; o <<= 1) v += __shfl_xor(v, o);
    return v;
}
__device__ __forceinline__ float fexp2(float x) { return __builtin_amdgcn_exp2f(x); }
__device__ __forceinline__ float frcp(float x) { return __builtin_amdgcn_rcpf(x); }
__device__ __forceinline__ float rstd_of(float ss) { return 1.0f / sqrtf(ss * (1.0f / 1024.0f) + EPS); }
__device__ __forceinline__ float rstd_row(const float* ssp, int row) { const f32x4* q = (const f32x4*)(ssp + (size_t)row * 16); const f32x4 t = (q[0] + q[1]) + (q[2] + q[3]); return rstd_of((t[0] + t[1]) + (t[2] + t[3])); }

using pg8::Unit;
template <int SCALE> struct EpiSwiglu {
    static constexpr bool PERM = true, AFTER_DRAIN = false;
    const LAS float* rl; bf16_t* H;
    __device__ __forceinline__ void operator()(const f32x4 (&acc)[2][2][4][2], const Unit& u, int wr, int wc, int fr, int fq, int ui) const {
#pragma unroll
        for (int ai = 0; ai < 2; ++ai)
#pragma unroll
            for (int m = 0; m < 4; ++m) {
                const int row = u.pm * 256 + ai * 128 + wr * 64 + m * 16 + fr; float rs = 1.0f; if constexpr (SCALE == 2) rs = rl[256 * ui + ai * 128 + wr * 64 + m * 16 + fr]; float h[8];
#pragma unroll
                for (int n = 0; n < 2; ++n) {
                    const f32x4 g = acc[ai][0][m][n] * rs, up = acc[ai][1][m][n] * rs;
#pragma unroll
                    for (int i = 0; i < 4; ++i) h[4 * n + i] = g[i] * frcp(1.0f + fexp2(-g[i] * LOG2E)) * up[i];
                }
                u32x4 w; w.x = pk2(h[0], h[1]); w.y = pk2(h[2], h[3]); w.z = pk2(h[4], h[5]); w.w = pk2(h[6], h[7]);
                *(u32x4*)(H + (size_t)row * DFF + u.pn * 128 + wc * 32 + fq * 8) = w;
            }
    }
};
struct EpiResid {
    static constexpr bool PERM = true, AFTER_DRAIN = false;
    const float* Rin32; const bf16_t* Rin16; bf16_t* Rb; float* ssout; float alpha;
    __device__ __forceinline__ void operator()(const f32x4 (&acc)[2][2][4][2], const Unit& u, int wr, int wc, int fr, int fq, int ui) const {
#pragma unroll
        for (int ai = 0; ai < 2; ++ai) {
            f32x4 pre[4][2][2];
#pragma unroll
            for (int m = 0; m < 4; ++m) { const int row = u.pm * 256 + ai * 128 + wr * 64 + m * 16 + fr;
#pragma unroll
                for (int bj = 0; bj < 2; ++bj) { const size_t off = (size_t)row * DM + u.pn * 256 + bj * 128 + wc * 32 + fq * 8;
                    if (Rin32) { pre[m][bj][0] = *(const f32x4*)(Rin32 + off); pre[m][bj][1] = *(const f32x4*)(Rin32 + off + 4); }
                    else { const u32x4 t = *(const u32x4*)(Rin16 + off);
                        pre[m][bj][0] = (f32x4){__builtin_bit_cast(float, t.x << 16), __builtin_bit_cast(float, t.x & 0xffff0000u), __builtin_bit_cast(float, t.y << 16), __builtin_bit_cast(float, t.y & 0xffff0000u)};
                        pre[m][bj][1] = (f32x4){__builtin_bit_cast(float, t.z << 16), __builtin_bit_cast(float, t.z & 0xffff0000u), __builtin_bit_cast(float, t.w << 16), __builtin_bit_cast(float, t.w & 0xffff0000u)}; } } }
#pragma unroll
            for (int m = 0; m < 4; ++m) {
                const int row = u.pm * 256 + ai * 128 + wr * 64 + m * 16 + fr; float sq = 0.f;
#pragma unroll
                for (int bj = 0; bj < 2; ++bj) {
                    const size_t off = (size_t)row * DM + u.pn * 256 + bj * 128 + wc * 32 + fq * 8;
                    const f32x4 o0 = pre[m][bj][0] + acc[ai][bj][m][0] * alpha, o1 = pre[m][bj][1] + acc[ai][bj][m][1] * alpha;
                    sq += ((o0[0] * o0[0] + o0[1] * o0[1]) + (o0[2] * o0[2] + o0[3] * o0[3])) + ((o1[0] * o1[0] + o1[1] * o1[1]) + (o1[2] * o1[2] + o1[3] * o1[3]));
                    u32x4 w; w.x = pk2(o0[0], o0[1]); w.y = pk2(o0[2], o0[3]); w.z = pk2(o1[0], o1[1]); w.w = pk2(o1[2], o1[3]); *(u32x4*)(Rb + off) = w;
                }
                sq += __shfl_xor(sq, 16); sq += __shfl_xor(sq, 32);
                if (fq == 0) ssout[(size_t)row * 16 + u.pn * 4 + wc] = sq;
            }
        }
    }
    __device__ __forceinline__ float mini(const f32x4 (&v)[2], int row, int col, int fq) const {
        float sq = 0.f;
#pragma unroll
        for (int jj = 0; jj < 2; ++jj) {
            const size_t off = (size_t)row * DM + col + 16 * jj; f32x4 r;
            if (Rin32) r = *(const f32x4*)(Rin32 + off);
            else { const u32x2 t = *(const u32x2*)(Rin16 + off); r = (f32x4){__builtin_bit_cast(float, t.x << 16), __builtin_bit_cast(float, t.x & 0xffff0000u), __builtin_bit_cast(float, t.y << 16), __builtin_bit_cast(float, t.y & 0xffff0000u)}; }
            const f32x4 o = r + v[jj] * alpha;
            sq += (o[0] * o[0] + o[1] * o[1]) + (o[2] * o[2] + o[3] * o[3]);
            u32x2 w; w.x = pk2(o[0], o[1]); w.y = pk2(o[2], o[3]); *(u32x2*)(Rb + off) = w;
        }
        sq += __shfl_xor(sq, 16); sq += __shfl_xor(sq, 32);
        return sq;
    }
    __device__ __forceinline__ void put_ss(int row, int slot, float v) const { ssout[(size_t)row * 16 + slot] = v; }
};
struct EpiResid2 { static constexpr bool PERM = true, AFTER_DRAIN = false; EpiResid p, s;
    __device__ __forceinline__ void operator()(const f32x4 (&acc)[2][2][4][2], const Unit& u, int wr, int wc, int fr, int fq, int ui) const { if (u.pm < 64) p(acc, u, wr, wc, fr, fq, ui); else s(acc, u, wr, wc, fr, fq, ui); } };
struct EpiInproj {
    static constexpr bool PERM = true, AFTER_DRAIN = false;
    const float* ss; float* U; bf16_t *Qb, *Kb, *Vb; float* out; const LAS float* rl;
    __device__ __forceinline__ void operator()(const f32x4 (&acc)[2][2][4][2], const Unit& u, int wr, int wc, int fr, int fq, int ui) const {
        const int kind = u.pn >> 1, cbase = (u.pn & 1) * 256;
#pragma unroll
        for (int ai = 0; ai < 2; ++ai)
#pragma unroll
            for (int m = 0; m < 4; ++m) {
                const int row = u.pm * 256 + ai * 128 + wr * 64 + m * 16 + fr; const float rs = rl[256 * ui + ai * 128 + wr * 64 + m * 16 + fr];
#pragma unroll
                for (int bj = 0; bj < 2; ++bj)
#pragma unroll
                    for (int n = 0; n < 2; ++n) {
                        const int col = cbase + bj * 128 + wc * 32 + fq * 8 + n * 4; const f32x4 v = acc[ai][bj][m][n] * rs;
                        const size_t off = (size_t)row * 512 + col;
                        if (kind == 0) { *(f32x4*)(U + off) = v; }
                        else if (kind == 1) { u32x2 w; w.x = pk2(v[0] * QS_DIFF, v[1] * QS_DIFF); w.y = pk2(v[2] * QS_DIFF, v[3] * QS_DIFF); *(u32x2*)(Qb + off) = w; }
                        else {
                            float* o = out + (kind == 2 ? (row < MP ? O_KP : O_KS) : (row < MP ? O_VP : O_VS)) + (size_t)(row < MP ? row : row - MP) * 512 + col;
                            *(f32x4*)o = v; u32x2 w; w.x = pk2(v[0], v[1]); w.y = pk2(v[2], v[3]); *(u32x2*)((kind == 2 ? Kb : Vb) + off) = w;
                        }
                    }
            }
    }
    __device__ __forceinline__ void put_ss(int, int, float) const {}
    __device__ __forceinline__ float mini(const f32x4 (&vv)[2], int row, int gcol, int fq) const {
        const float rs = rstd_row(ss, row); const int kind = gcol >> 9;
#pragma unroll
        for (int jj = 0; jj < 2; ++jj) {
            const int col = (gcol & 511) + 16 * jj; const f32x4 v = vv[jj] * rs; const size_t off = (size_t)row * 512 + col;
            if (kind == 0) { *(f32x4*)(U + off) = v; }
            else if (kind == 1) { u32x2 w; w.x = pk2(v[0] * QS_DIFF, v[1] * QS_DIFF); w.y = pk2(v[2] * QS_DIFF, v[3] * QS_DIFF); *(u32x2*)(Qb + off) = w; }
            else {
                float* o = out + (kind == 2 ? (row < MP ? O_KP : O_KS) : (row < MP ? O_VP : O_VS)) + (size_t)(row < MP ? row : row - MP) * 512 + col;
                *(f32x4*)o = v; u32x2 w; w.x = pk2(v[0], v[1]); w.y = pk2(v[2], v[3]); *(u32x2*)((kind == 2 ? Kb : Vb) + off) = w;
            }
        }
        return 0.f;
    }
};
struct EpiGlu {
    static constexpr bool PERM = true, AFTER_DRAIN = false;
    const bf16_t* Y; const float* bias; bf16_t* CAT;
    __device__ __forceinline__ void operator()(const f32x4 (&acc)[2][2][4][2], const Unit& u, int wr, int wc, int fr, int fq, int ui) const {
#pragma unroll
        for (int ai = 0; ai < 2; ++ai)
#pragma unroll
            for (int m = 0; m < 4; ++m) {
                const int row = u.pm * 256 + ai * 128 + wr * 64 + m * 16 + fr;
#pragma unroll
                for (int bj = 0; bj < 2; ++bj)
#pragma unroll
                    for (int n = 0; n < 2; ++n) {
                        const int col = u.pn * 256 + bj * 128 + wc * 32 + fq * 8 + n * 4;
                        const u32x2 yv = *(const u32x2*)(Y + (size_t)row * 512 + col); const f32x4 bv = *(const f32x4*)(bias + col);
                        const float y0 = __builtin_bit_cast(float, yv.x << 16), y1 = __builtin_bit_cast(float, yv.x & 0xffff0000u), y2 = __builtin_bit_cast(float, yv.y << 16), y3 = __builtin_bit_cast(float, yv.y & 0xffff0000u);
                        const f32x4 z = acc[ai][bj][m][n] + bv;
                        const float o0 = y0 * frcp(1.f + fexp2(-z[0] * LOG2E)), o1 = y1 * frcp(1.f + fexp2(-z[1] * LOG2E)), o2 = y2 * frcp(1.f + fexp2(-z[2] * LOG2E)), o3 = y3 * frcp(1.f + fexp2(-z[3] * LOG2E));
                        u32x2 w; w.x = pk2(o0, o1); w.y = pk2(o2, o3); *(u32x2*)(CAT + (size_t)row * DM + col) = w;
                    }
            }
    }
};
struct EpiScaleBf16 {
    static constexpr bool PERM = true, AFTER_DRAIN = false;
    const float* ss; bf16_t* O; float sc;
    __device__ __forceinline__ void operator()(const f32x4 (&acc)[2][2][4][2], const Unit& u, int wr, int wc, int fr, int fq, int ui) const {
#pragma unroll
        for (int ai = 0; ai < 2; ++ai)
#pragma unroll
            for (int m = 0; m < 4; ++m) {
                const int row = u.pm * 256 + ai * 128 + wr * 64 + m * 16 + fr; const float rs = rstd_row(ss, row) * sc;
#pragma unroll
                for (int bj = 0; bj < 2; ++bj)
#pragma unroll
                    for (int n = 0; n < 2; ++n) {
                        const f32x4 v = acc[ai][bj][m][n] * rs; u32x2 w; w.x = pk2(v[0], v[1]); w.y = pk2(v[2], v[3]);
                        *(u32x2*)(O + (size_t)row * DM + u.pn * 256 + bj * 128 + wc * 32 + fq * 8 + n * 4) = w;
                    }
            }
    }
    __device__ __forceinline__ void put_ss(int, int, float) const {}
    __device__ __forceinline__ float mini(const f32x4 (&vv)[2], int row, int col, int fq) const {
        const float rs = rstd_row(ss, row) * sc;
#pragma unroll
        for (int jj = 0; jj < 2; ++jj) { const f32x4 v = vv[jj] * rs; u32x2 w; w.x = pk2(v[0], v[1]); w.y = pk2(v[2], v[3]); *(u32x2*)(O + (size_t)row * DM + col + 16 * jj) = w; }
        return 0.f;
    }
};
struct EpiMem {
    static constexpr bool PERM = true, AFTER_DRAIN = false;
    const float* ss; float* out; bf16_t *MK, *MV;
    __device__ __forceinline__ void operator()(const f32x4 (&acc)[2][2][4][2], const Unit& u, int wr, int wc, int fr, int fq, int ui) const {
        const int kind = u.pn >> 2, cbase = (u.pn & 3) * 256;
#pragma unroll
        for (int ai = 0; ai < 2; ++ai)
#pragma unroll
            for (int m = 0; m < 4; ++m) {
                const int row = u.pm * 256 + ai * 128 + wr * 64 + m * 16 + fr; const float rs = rstd_row(ss, row);
#pragma unroll
                for (int bj = 0; bj < 2; ++bj)
#pragma unroll
                    for (int n = 0; n < 2; ++n) {
                        const size_t off = (size_t)row * DM + cbase + bj * 128 + wc * 32 + fq * 8 + n * 4; const f32x4 v = acc[ai][bj][m][n] * rs;
                        *(f32x4*)(out + (kind ? O_MVP : O_MKP) + off) = v; u32x2 w; w.x = pk2(v[0], v[1]); w.y = pk2(v[2], v[3]); *(u32x2*)((kind ? MV : MK) + off) = w;
                    }
            }
    }
};

template <class Epi>
__device__ __forceinline__ void mini_gemm(LAS unsigned char* lds, const bf16_t* A, const bf16_t* Bt, int K, int r0, int c0, const Epi& E) {
    const int tid = threadIdx.x, lane = tid & 63, fr = lane & 15, g4 = lane >> 4, w = __builtin_amdgcn_readfirstlane(tid >> 6);
    const int ksteps = K / 256, kbeg = w * ksteps * 32;
    f32x4 acc[4][4];
#pragma unroll
    for (int i = 0; i < 4; ++i)
#pragma unroll
        for (int j = 0; j < 4; ++j) acc[i][j] = (f32x4){0.f, 0.f, 0.f, 0.f};
    const bf16_t* ap = A + (size_t)(r0 + fr) * K + kbeg + 8 * g4;
    const bf16_t* bp = Bt + (size_t)(c0 + fr) * K + kbeg + 8 * g4;
#pragma unroll 4
    for (int s_ = 0; s_ < ksteps; ++s_) {
        bf16x8 af[4], bf[4];
#pragma unroll
        for (int i = 0; i < 4; ++i) af[i] = *(const bf16x8*)(ap + (size_t)(16 * i) * K + 32 * s_);
#pragma unroll
        for (int j = 0; j < 4; ++j) bf[j] = *(const bf16x8*)(bp + (size_t)(16 * j) * K + 32 * s_);
#pragma unroll
        for (int i = 0; i < 4; ++i)
#pragma unroll
            for (int j = 0; j < 4; ++j) acc[i][j] = __builtin_amdgcn_mfma_f32_16x16x32_bf16(bf[j], af[i], acc[i][j], 0, 0, 0);
    }
    LAS f32x4* P = (LAS f32x4*)lds;
#pragma unroll
    for (int i = 0; i < 4; ++i)
#pragma unroll
        for (int j = 0; j < 4; ++j) P[(w * 16 + i * 4 + j) * 64 + lane] = acc[i][j];
    __syncthreads();
    const int i = w >> 1, jb = (w & 1) * 2;
    f32x4 sum[2];
#pragma unroll
    for (int jj = 0; jj < 2; ++jj) { sum[jj] = (f32x4){0.f, 0.f, 0.f, 0.f};
#pragma unroll
        for (int ww = 0; ww < 8; ++ww) sum[jj] += P[(ww * 16 + i * 4 + jb + jj) * 64 + lane]; }
    const float sq = E.mini(sum, r0 + 16 * i + fr, c0 + 16 * jb + 4 * g4, g4);
    LAS float* SQ = (LAS float*)(lds + 131072);
    if (g4 == 0) SQ[w * 16 + fr] = sq;
    __syncthreads();
    if (tid < 64) E.put_ss(r0 + tid, c0 >> 6, SQ[(2 * (tid >> 4)) * 16 + (tid & 15)] + SQ[(2 * (tid >> 4) + 1) * 16 + (tid & 15)]);
    __syncthreads();
}

__device__ __forceinline__ int gu_row(int nn) { return nn < DFF ? ((nn >> 7) * 256 + (nn & 127)) : (((nn - DFF) >> 7) * 256 + 128 + ((nn - DFF) & 127)); }
__device__ __forceinline__ void tr_item(const float* W, int K, int N, bf16_t* WT, const float* g, int gumode, int rowoff, LAS float* scr, int item, int lane) {
    const int nblk = N / 32, kb = item / nblk, nb = item % nblk, k0 = 64 * kb, n0 = 32 * nb;
    float tv[32];
#pragma unroll
    for (int i = 0; i < 32; ++i) { const int kk = 2 * i + (lane >> 5); tv[i] = W[(size_t)(k0 + kk) * N + n0 + (lane & 31)]; }
#pragma unroll
    for (int i = 0; i < 32; ++i) { const int kk = 2 * i + (lane >> 5); float v = tv[i]; if (g) v *= g[k0 + kk]; scr[kk * 33 + (lane & 31)] = v; }
    asm volatile("s_waitcnt lgkmcnt(0)" ::: "memory");
    const int c = lane & 7;
#pragma unroll
    for (int j = 0; j < 4; ++j) { const int n = (lane >> 3) + 8 * j; const LAS float* s = scr + (8 * c) * 33 + n;
        u32x4 o; o.x = pk2(s[0 * 33], s[1 * 33]); o.y = pk2(s[2 * 33], s[3 * 33]); o.z = pk2(s[4 * 33], s[5 * 33]); o.w = pk2(s[6 * 33], s[7 * 33]);
        const int nn = n0 + n; const int dr = gumode ? gu_row(nn) : rowoff + nn;
        *(u32x4*)(WT + (size_t)dr * K + k0 + 8 * c) = o; }
    asm volatile("s_waitcnt lgkmcnt(0)" ::: "memory");
}
__device__ __forceinline__ void row_to_bf16(const float* src, bf16_t* dst, float* ssout, int lane) {
    const f32x4* xr = (const f32x4*)src + lane; f32x4 v[4]; float s = 0.f;
#pragma unroll
    for (int j = 0; j < 4; ++j) { v[j] = xr[64 * j]; s += (v[j][0] * v[j][0] + v[j][1] * v[j][1]) + (v[j][2] * v[j][2] + v[j][3] * v[j][3]); }
    u32x2* o = (u32x2*)dst + lane;
#pragma unroll
    for (int j = 0; j < 4; ++j) { u32x2 w; w.x = pk2(v[j][0], v[j][1]); w.y = pk2(v[j][2], v[j][3]); o[64 * j] = w; }
    if (ssout) { s = wave_sum(s); if (lane < 16) ssout[lane] = lane == 0 ? s : 0.f; }
}

__device__ __forceinline__ s16x4 tr_read(const LAS unsigned char* p) { return __builtin_amdgcn_ds_read_tr16_b64_v4i16((LAS s16x4*)p); }

template <int KROW, int VROW, int KSTR, int VSTR> struct LoaderBf16 {
    const bf16_t* kbase; const bf16_t* vbase; size_t pitch;
    static constexpr int KCH = KROW / 8, VCH = VROW / 8, NK = 64 * KCH / 512, NV = 64 * VCH / 512;
    u32x4 kr[NK], vr[NV];
    __device__ __forceinline__ void issue(int t, int tid) {
#pragma unroll
        for (int i = 0; i < NK; ++i) { const int c = tid + 512 * i, row = c / KCH, ch = c % KCH; kr[i] = *(const u32x4*)(kbase + (size_t)(64 * t + row) * pitch + ch * 8); }
#pragma unroll
        for (int i = 0; i < NV; ++i) { const int c = tid + 512 * i, row = c / VCH, ch = c % VCH; vr[i] = *(const u32x4*)(vbase + (size_t)(64 * t + row) * pitch + ch * 8); }
    }
    __device__ __forceinline__ void commit(LAS unsigned char* kl, LAS unsigned char* vl, int tid) {
#pragma unroll
        for (int i = 0; i < NK; ++i) { const int c = tid + 512 * i, row = c / KCH, ch = c % KCH; *(LAS u32x4*)(kl + row * KSTR + ch * 16) = kr[i]; }
#pragma unroll
        for (int i = 0; i < NV; ++i) { const int c = tid + 512 * i, row = c / VCH, ch = c % VCH; *(LAS u32x4*)(vl + row * VSTR + ch * 16) = vr[i]; }
    }
};
template <int KSTR, int VSTR> struct LoaderF32 {
    const float *kc, *vc, *kn, *vn;
    f32x4 kr[4], vr[4];
    __device__ __forceinline__ void issue(int t, int tid) {
        const float* kb = t < 64 ? kc + (size_t)(64 * t) * 512 : kn; const float* vb = t < 64 ? vc + (size_t)(64 * t) * 512 : vn;
#pragma unroll
        for (int i = 0; i < 4; ++i) { const int c = tid + 512 * i, row = c >> 5, ch = c & 31; kr[i] = __builtin_nontemporal_load((const f32x4*)(kb + (size_t)row * 512 + ch * 4)); vr[i] = __builtin_nontemporal_load((const f32x4*)(vb + (size_t)row * 512 + ch * 4)); }
    }
    __device__ __forceinline__ void commit(LAS unsigned char* kl, LAS unsigned char* vl, int tid) {
#pragma unroll
        for (int i = 0; i < 4; ++i) { const int c = tid + 512 * i, row = c >> 5, ch = c & 31;
            u32x2 a; a.x = pk2(kr[i][0], kr[i][1]); a.y = pk2(kr[i][2], kr[i][3]); *(LAS u32x2*)(kl + row * KSTR + ch * 8) = a;
            u32x2 b; b.x = pk2(vr[i][0], vr[i][1]); b.y = pk2(vr[i][2], vr[i][3]); *(LAS u32x2*)(vl + row * VSTR + ch * 8) = b; }
    }
};

template <int NQ, int DQK, int DV, int KSTR, int VSTR, bool ALIBI>
__device__ __forceinline__ void flash_tile(int t, LAS unsigned char* kl, LAS unsigned char* vl, const bf16x8 (&qf)[NQ][DQK / 32], int koffB, float slope2, const float (&qposf)[NQ],
                                           f32x4 (&o)[NQ][DV / 16], float (&m)[NQ], float (&l)[NQ]) {
    const int lane = threadIdx.x & 63, fr = lane & 15, g4 = lane >> 4;
    f32x4 s[NQ][4];
#pragma unroll
    for (int kb = 0; kb < 4; ++kb) {
#pragma unroll
        for (int q = 0; q < NQ; ++q) s[q][kb] = (f32x4){0.f, 0.f, 0.f, 0.f};
#pragma unroll
        for (int ks = 0; ks < DQK / 32; ++ks) { const bf16x8 a = *(const LAS bf16x8*)(kl + (16 * kb + fr) * KSTR + koffB + ks * 64 + g4 * 16);
#pragma unroll
            for (int q = 0; q < NQ; ++q) s[q][kb] = __builtin_amdgcn_mfma_f32_16x16x32_bf16(a, qf[q][ks], s[q][kb], 0, 0, 0); } }
    bf16x8 pf[NQ][2];
#pragma unroll
    for (int q = 0; q < NQ; ++q) {
        if (ALIBI) { const float d0 = qposf[q] - (float)(64 * t + 4 * g4);
#pragma unroll
            for (int kb = 0; kb < 4; ++kb)
#pragma unroll
                for (int r = 0; r < 4; ++r) s[q][kb][r] -= slope2 * __builtin_fabsf(d0 - (float)(16 * kb + r)); }
        float mx = s[q][0][0];
#pragma unroll
        for (int kb = 0; kb < 4; ++kb)
#pragma unroll
            for (int r = 0; r < 4; ++r) mx = __builtin_fmaxf(mx, s[q][kb][r]);
        mx = __builtin_fmaxf(mx, __shfl_xor(mx, 16)); mx = __builtin_fmaxf(mx, __shfl_xor(mx, 32));
        const float mn = __builtin_fmaxf(m[q], mx), alpha = fexp2(m[q] - mn); m[q] = mn;
        float ps = 0.f;
#pragma unroll
        for (int kb = 0; kb < 4; ++kb)
#pragma unroll
            for (int r = 0; r < 4; ++r) { s[q][kb][r] = fexp2(s[q][kb][r] - mn); ps += s[q][kb][r]; }
        l[q] = l[q] * alpha + ps;
#pragma unroll
        for (int vb = 0; vb < DV / 16; ++vb) o[q][vb] = o[q][vb] * alpha;
#pragma unroll
        for (int s2 = 0; s2 < 2; ++s2) { u32x4 w; w.x = pk2(s[q][2 * s2][0], s[q][2 * s2][1]); w.y = pk2(s[q][2 * s2][2], s[q][2 * s2][3]); w.z = pk2(s[q][2 * s2 + 1][0], s[q][2 * s2 + 1][1]); w.w = pk2(s[q][2 * s2 + 1][2], s[q][2 * s2 + 1][3]);
            pf[q][s2] = __builtin_bit_cast(bf16x8, w); }
    }
    const LAS unsigned char* vbase = vl + (4 * g4 + (fr >> 2)) * VSTR + (fr & 3) * 8;
#pragma unroll
    for (int vb = 0; vb < DV / 16; ++vb)
#pragma unroll
        for (int s2 = 0; s2 < 2; ++s2) {
            const s16x4 lo = tr_read(vbase + (32 * s2) * VSTR + vb * 32), hi = tr_read(vbase + (32 * s2 + 16) * VSTR + vb * 32);
            const bf16x8 a = (bf16x8){lo[0], lo[1], lo[2], lo[3], hi[0], hi[1], hi[2], hi[3]};
#pragma unroll
            for (int q = 0; q < NQ; ++q) o[q][vb] = __builtin_amdgcn_mfma_f32_16x16x32_bf16(a, pf[q][s2], o[q][vb], 0, 0, 0);
        }
}
template <int NQ, int DQK, int DV, int KSTR, int VSTR, bool ALIBI, bool DEEP, class Loader>
__device__ __forceinline__ void flash_loop(Loader& L, int t0, int t1, int tact, LAS unsigned char* lds, const bf16x8 (&qf)[NQ][DQK / 32], int koffB, float slope2, const float (&qposf)[NQ],
                                           f32x4 (&o)[NQ][DV / 16], float (&m)[NQ], float (&l)[NQ]) {
    const int tid = threadIdx.x;
    constexpr int KB = 64 * KSTR, VB = 64 * VSTR;
    LAS unsigned char* k0 = lds; LAS unsigned char* v0 = lds + KB; LAS unsigned char* k1 = lds + KB + VB; LAS unsigned char* v1 = k1 + KB;
    if constexpr (DEEP) {
        Loader L2 = L;
        L.issue(t0, tid); if (t0 + 1 < t1) L2.issue(t0 + 1, tid);
        for (int t = t0; t < t1; t += 2) {
            L.commit(k0, v0, tid);
            __syncthreads();
            if (t + 2 < t1) L.issue(t + 2, tid);
            if (t < tact) flash_tile<NQ, DQK, DV, KSTR, VSTR, ALIBI>(t, k0, v0, qf, koffB, slope2, qposf, o, m, l);
            if (t + 1 < t1) {
                L2.commit(k1, v1, tid);
                __syncthreads();
                if (t + 3 < t1) L2.issue(t + 3, tid);
                if (t + 1 < tact) flash_tile<NQ, DQK, DV, KSTR, VSTR, ALIBI>(t + 1, k1, v1, qf, koffB, slope2, qposf, o, m, l);
            }
        }
    } else {
    L.issue(t0, tid);
    for (int t = t0; t < t1; ++t) {
        const int buf = (t - t0) & 1;
        LAS unsigned char* kl = buf ? k1 : k0; LAS unsigned char* vl = buf ? v1 : v0;
        L.commit(kl, vl, tid);
        __syncthreads();
        if (t + 1 < t1) L.issue(t + 1, tid);
        if (t < tact) flash_tile<NQ, DQK, DV, KSTR, VSTR, ALIBI>(t, kl, vl, qf, koffB, slope2, qposf, o, m, l);
    }
    }
    __syncthreads();
}

constexpr int DK_STR = 272, DV_STR = 288;
constexpr int CK_STR = 528, CV_STR = 544;

__device__ __forceinline__ void diff_prompt_unit(const Args& a, LAS unsigned char* lds, int b, int h, int cp, float lam) {
    const int tid = threadIdx.x, lane = tid & 63, fr = lane & 15, g4 = lane >> 4, w = __builtin_amdgcn_readfirstlane(tid >> 6), map = w & 1, qq = w >> 1;
    const bf16_t* Qb = (const bf16_t*)(a.ws + W_QB); const bf16_t* Kb = (const bf16_t*)(a.ws + W_KB); const bf16_t* Vb = (const bf16_t*)(a.ws + W_VB);
    bf16x8 qf[2][2]; float qposf[2];
#pragma unroll
    for (int q = 0; q < 2; ++q) { const int pos = 128 * cp + 32 * qq + 16 * q + fr; qposf[q] = (float)pos;
#pragma unroll
        for (int ks = 0; ks < 2; ++ks) qf[q][ks] = *(const bf16x8*)(Qb + (size_t)(b * SEQ + pos) * 512 + h * 128 + map * 64 + 32 * ks + 8 * g4); }
    LoaderBf16<128, 128, DK_STR, DV_STR> L; L.kbase = Kb + (size_t)(b * SEQ) * 512 + h * 128; L.vbase = Vb + (size_t)(b * SEQ) * 512 + h * 128; L.pitch = 512;
    f32x4 o[2][8]; float m[2], l[2];
#pragma unroll
    for (int q = 0; q < 2; ++q) { m[q] = -INFINITY; l[q] = 0.f;
#pragma unroll
        for (int i = 0; i < 8; ++i) o[q][i] = (f32x4){0.f, 0.f, 0.f, 0.f}; }
    const float slope2 = exp2f(-2.0f * (float)(h + 1)) * LOG2E;
    flash_loop<2, 64, 128, DK_STR, DV_STR, true, false>(L, 0, 2 * cp + 2, 2 * cp + 1 + (qq >> 1), lds, qf, map * 128, slope2, qposf, o, m, l);
    LAS float* stg = (LAS float*)lds;
#pragma unroll
    for (int q = 0; q < 2; ++q) { float lt = l[q]; lt += __shfl_xor(lt, 16); lt += __shfl_xor(lt, 32); const float inv = 1.0f / lt;
#pragma unroll
        for (int vb = 0; vb < 8; ++vb) *(LAS f32x4*)(stg + (map * 128 + 32 * qq + 16 * q + fr) * 132 + 16 * vb + 4 * g4) = o[q][vb] * inv; }
    __syncthreads();
#pragma unroll
    for (int it = 0; it < 2; ++it) {
        const int idx = tid + 512 * it, q = idx >> 3, seg = idx & 7; const float* gs = a.in[26] + 16 * seg;
        float d[16]; float ss = 0.f;
#pragma unroll
        for (int i = 0; i < 16; i += 4) { const f32x4 o1 = *(const LAS f32x4*)(stg + q * 132 + 16 * seg + i), o2 = *(const LAS f32x4*)(stg + (128 + q) * 132 + 16 * seg + i);
#pragma unroll
            for (int j = 0; j < 4; ++j) { d[i + j] = o1[j] - lam * o2[j]; ss += d[i + j] * d[i + j]; } }
        ss += __shfl_xor(ss, 1); ss += __shfl_xor(ss, 2); ss += __shfl_xor(ss, 4);
        const float rn = (1.0f - LAM_INIT) / sqrtf(ss * (1.0f / 128.0f) + EPS);
        bf16_t* CAT = (bf16_t*)(a.ws + W_CAT) + (size_t)(b * SEQ + 128 * cp + q) * DM + 512 + h * 128 + 16 * seg;
        u32x4 w0, w1;
        w0.x = pk2(d[0] * rn * gs[0], d[1] * rn * gs[1]); w0.y = pk2(d[2] * rn * gs[2], d[3] * rn * gs[3]); w0.z = pk2(d[4] * rn * gs[4], d[5] * rn * gs[5]); w0.w = pk2(d[6] * rn * gs[6], d[7] * rn * gs[7]);
        w1.x = pk2(d[8] * rn * gs[8], d[9] * rn * gs[9]); w1.y = pk2(d[10] * rn * gs[10], d[11] * rn * gs[11]); w1.z = pk2(d[12] * rn * gs[12], d[13] * rn * gs[13]); w1.w = pk2(d[14] * rn * gs[14], d[15] * rn * gs[15]);
        *(u32x4*)CAT = w0; *(u32x4*)(CAT + 8) = w1;
    }
    __syncthreads();
}
__device__ __forceinline__ void diff_sample_unit(const Args& a, LAS unsigned char* lds, int b, int h, int sp) {
    const int tid = threadIdx.x, lane = tid & 63, fr = lane & 15, g4 = lane >> 4, w = __builtin_amdgcn_readfirstlane(tid >> 6), map = w & 1, qg = w >> 1;
    const bf16_t* Qb = (const bf16_t*)(a.ws + W_QB);
    const int row = MP + b * 64 + 16 * qg + fr;
    bf16x8 qf[1][2];
#pragma unroll
    for (int ks = 0; ks < 2; ++ks) qf[0][ks] = *(const bf16x8*)(Qb + (size_t)row * 512 + h * 128 + map * 64 + 32 * ks + 8 * g4);
    LoaderF32<DK_STR, DV_STR> L;
    L.kc = a.in[2] + ((size_t)b * PAST * 4 + h) * 128; L.vc = a.in[3] + ((size_t)b * PAST * 4 + h) * 128;
    L.kn = a.out + O_KS + ((size_t)b * 64 * 4 + h) * 128; L.vn = a.out + O_VS + ((size_t)b * 64 * 4 + h) * 128;
    f32x4 o[1][8];
#pragma unroll
    for (int i = 0; i < 8; ++i) o[0][i] = (f32x4){0.f, 0.f, 0.f, 0.f};
    float m[1] = {-INFINITY}, l[1] = {0.f};
    const float slope2 = exp2f(-2.0f * (float)(h + 1)) * LOG2E;
    const int t0 = 16 * sp, t1 = sp == 3 ? 65 : 16 * sp + 16;
    const float qposf[1] = {(float)(PAST + 16 * qg + fr)};
    flash_loop<1, 64, 128, DK_STR, DV_STR, true, true>(L, t0, t1, t1, lds, qf, map * 128, slope2, qposf, o, m, l);
    float lt = l[0]; lt += __shfl_xor(lt, 16); lt += __shfl_xor(lt, 32);
    const int pidx = (((b * 4 + h) * 4 + sp) * 2 + map) * 64 + 16 * qg + fr;
    float* P = (float*)(a.ws + W_PART) + (size_t)pidx * 128; float* ML = (float*)(a.ws + W_ML) + (size_t)pidx * 2;
#pragma unroll
    for (int vb = 0; vb < 8; ++vb) *(f32x4*)(P + 16 * vb + 4 * g4) = o[0][vb];
    if (g4 == 0) { ML[0] = m[0]; ML[1] = lt; }
}
__device__ __forceinline__ void cross_unit(const Args& a, LAS unsigned char* lds, int bb, int h, int qblk) {
    const int tid = threadIdx.x, lane = tid & 63, fr = lane & 15, g4 = lane >> 4, w = __builtin_amdgcn_readfirstlane(tid >> 6);
    const bf16_t* QC = (const bf16_t*)(a.ws + W_QC); bf16_t* OC = (bf16_t*)(a.ws + W_OC);
    const bool valid = bb < 8 || w < 4;
    const int row = bb < 8 ? bb * SEQ + 128 * qblk + 16 * w + fr : MP + (bb - 8) * 64 + 16 * (w & 3) + fr;
    const bf16_t* kbase = (const bf16_t*)(a.ws + W_MK) + (size_t)(bb * 256) * DM + h * 256; const bf16_t* vbase_g = (const bf16_t*)(a.ws + W_MV) + (size_t)(bb * 256) * DM + h * 256;
    constexpr int VHALF = 128 * CV_STR;
    u32x4 kr[16];
#pragma unroll
    for (int i = 0; i < 16; ++i) { const int c = tid + 512 * i; kr[i] = *(const u32x4*)(kbase + (size_t)(c >> 5) * DM + (c & 31) * 8); }
    bf16x8 qf[8];
#pragma unroll
    for (int ks = 0; ks < 8; ++ks) qf[ks] = *(const bf16x8*)(QC + (size_t)row * DM + h * 256 + 32 * ks + 8 * g4);
#pragma unroll
    for (int i = 0; i < 16; ++i) { const int c = tid + 512 * i; *(LAS u32x4*)(lds + (c >> 5) * CK_STR + (c & 31) * 16) = kr[i]; }
    __syncthreads();
    u32x4 vr[8];
#pragma unroll
    for (int i = 0; i < 8; ++i) { const int c = tid + 512 * i; vr[i] = *(const u32x4*)(vbase_g + (size_t)(c >> 5) * DM + (c & 31) * 8); }
    f32x4 s[4][4];
#pragma unroll
    for (int kt = 0; kt < 4; ++kt) {
        const LAS unsigned char* kp = lds + (64 * kt + fr) * CK_STR + g4 * 16; asm volatile("" : "+v"(kp));
#pragma unroll
        for (int kb = 0; kb < 4; ++kb) { s[kt][kb] = (f32x4){0.f, 0.f, 0.f, 0.f};
#pragma unroll
            for (int ks = 0; ks < 8; ++ks) { const bf16x8 ka = *(const LAS bf16x8*)(kp + (16 * kb) * CK_STR + ks * 64);
                s[kt][kb] = __builtin_amdgcn_mfma_f32_16x16x32_bf16(ka, qf[ks], s[kt][kb], 0, 0, 0); } } }
    float mx = s[0][0][0];
#pragma unroll
    for (int kt = 0; kt < 4; ++kt)
#pragma unroll
        for (int kb = 0; kb < 4; ++kb)
#pragma unroll
            for (int r = 0; r < 4; ++r) mx = __builtin_fmaxf(mx, s[kt][kb][r]);
    mx = __builtin_fmaxf(mx, __shfl_xor(mx, 16)); mx = __builtin_fmaxf(mx, __shfl_xor(mx, 32));
    float lt = 0.f; bf16x8 pf[4][2];
#pragma unroll
    for (int kt = 0; kt < 4; ++kt) {
#pragma unroll
        for (int kb = 0; kb < 4; ++kb)
#pragma unroll
            for (int r = 0; r < 4; ++r) { s[kt][kb][r] = fexp2(s[kt][kb][r] - mx); lt += s[kt][kb][r]; }
#pragma unroll
        for (int s2 = 0; s2 < 2; ++s2) { u32x4 wv; wv.x = pk2(s[kt][2 * s2][0], s[kt][2 * s2][1]); wv.y = pk2(s[kt][2 * s2][2], s[kt][2 * s2][3]); wv.z = pk2(s[kt][2 * s2 + 1][0], s[kt][2 * s2 + 1][1]); wv.w = pk2(s[kt][2 * s2 + 1][2], s[kt][2 * s2 + 1][3]);
            pf[kt][s2] = __builtin_bit_cast(bf16x8, wv); }
    }
    lt += __shfl_xor(lt, 16); lt += __shfl_xor(lt, 32);
    __syncthreads();
#pragma unroll
    for (int i = 0; i < 8; ++i) { const int c = tid + 512 * i; *(LAS u32x4*)(lds + (c >> 5) * CV_STR + (c & 31) * 16) = vr[i]; }
#pragma unroll
    for (int i = 0; i < 8; ++i) { const int c = tid + 512 * i; vr[i] = *(const u32x4*)(vbase_g + (size_t)(128 + (c >> 5)) * DM + (c & 31) * 8); }
    __syncthreads();
    f32x4 o[16];
#pragma unroll
    for (int i = 0; i < 16; ++i) o[i] = (f32x4){0.f, 0.f, 0.f, 0.f};
    const LAS unsigned char* vb0 = lds + (4 * g4 + (fr >> 2)) * CV_STR + (fr & 3) * 8; asm volatile("" : "+v"(vb0));
    const LAS unsigned char* vb1 = vb0 + VHALF; asm volatile("" : "+v"(vb1));
#pragma unroll
    for (int vb = 0; vb < 16; ++vb)
#pragma unroll
        for (int s4 = 0; s4 < 4; ++s4) {
            const s16x4 lo = tr_read(vb0 + (32 * s4) * CV_STR + vb * 32), hi = tr_read(vb0 + (32 * s4 + 16) * CV_STR + vb * 32);
            const bf16x8 va = (bf16x8){lo[0], lo[1], lo[2], lo[3], hi[0], hi[1], hi[2], hi[3]};
            o[vb] = __builtin_amdgcn_mfma_f32_16x16x32_bf16(va, pf[s4 >> 1][s4 & 1], o[vb], 0, 0, 0);
        }
#pragma unroll
    for (int i = 0; i < 8; ++i) { const int c = tid + 512 * i; *(LAS u32x4*)(lds + VHALF + (c >> 5) * CV_STR + (c & 31) * 16) = vr[i]; }
    __syncthreads();
#pragma unroll
    for (int vb = 0; vb < 16; ++vb)
#pragma unroll
        for (int s4 = 0; s4 < 4; ++s4) {
            const s16x4 lo = tr_read(vb1 + (32 * s4) * CV_STR + vb * 32), hi = tr_read(vb1 + (32 * s4 + 16) * CV_STR + vb * 32);
            const bf16x8 va = (bf16x8){lo[0], lo[1], lo[2], lo[3], hi[0], hi[1], hi[2], hi[3]};
            o[vb] = __builtin_amdgcn_mfma_f32_16x16x32_bf16(va, pf[2 + (s4 >> 1)][s4 & 1], o[vb], 0, 0, 0);
        }
    const float inv = 1.0f / lt;
    if (valid) {
#pragma unroll
        for (int vb = 0; vb < 16; ++vb) { const f32x4 v = o[vb] * inv; u32x2 wv; wv.x = pk2(v[0], v[1]); wv.y = pk2(v[2], v[3]); *(u32x2*)(OC + (size_t)row * DM + h * 256 + 16 * vb + 4 * g4) = wv; }
    }
    __syncthreads();
}

constexpr int S5_BU_STR = 132, S5_HS_STR = 136;
constexpr int S5_YSTG = 16 * S5_BU_STR * 4 + 16 * S5_HS_STR * 2;
constexpr int S5_WAVE_BYTES = S5_YSTG + 4096;
struct S5Frags { bf16x8 bb[8]; bf16x8 cc[4]; f32x4 dsk; float ar, ai; };
__device__ __forceinline__ bf16x8 pack8(const float* p) { u32x4 w; w.x = pk2(p[0], p[1]); w.y = pk2(p[2], p[3]); w.z = pk2(p[4], p[5]); w.w = pk2(p[6], p[7]); return __builtin_bit_cast(bf16x8, w); }
__device__ __forceinline__ void s5_load_frags(const Args& a, int g, int lane, S5Frags& F) {
    const int fr = lane & 15, g4 = lane >> 4;
    const float* BBAR = (const float*)(a.ws + W_BBAR); const float* ABAR = (const float*)(a.ws + W_ABAR);
#pragma unroll
    for (int nb = 0; nb < 8; ++nb) {
        const int pcol = 16 * nb + fr, part = pcol & 1, p = pcol >> 1;
        if (g4 < 2) F.bb[nb] = pack8(BBAR + ((size_t)((g * 2 + part) * 64 + p)) * 16 + 8 * g4); else F.bb[nb] = (bf16x8){0, 0, 0, 0, 0, 0, 0, 0};
    }
#pragma unroll
    for (int ks = 0; ks < 4; ++ks) {
        const size_t co = ((size_t)(g * 16 + fr)) * 64 + 16 * ks + 4 * g4; float t[8];
#pragma unroll
        for (int j = 0; j < 4; ++j) { t[2 * j] = a.in[19][co + j]; t[2 * j + 1] = -a.in[20][co + j]; }
        F.cc[ks] = pack8(t);
    }
    F.dsk = *(const f32x4*)(a.in[21] + g * 16 + 4 * g4);
    F.ar = ABAR[(g * 64 + lane) * 2]; F.ai = ABAR[(g * 64 + lane) * 2 + 1];
}
template <bool WRITE> __device__ __forceinline__ void s5_run(const Args& a, const S5Frags& F, int g, int r0, int nch, float& sre, float& sim, LAS unsigned char* wl, int lane) {
    const int fr = lane & 15, g4 = lane >> 4;
    const float* U = (const float*)(a.ws + W_U); bf16_t* YACT = (bf16_t*)(a.ws + W_YACT);
    LAS float* bu = (LAS float*)wl; LAS bf16_t* hs = (LAS bf16_t*)(wl + 16 * S5_BU_STR * 4);
    f32x4 ring[2][3];
#pragma unroll
    for (int k = 0; k < 2; ++k) { ring[k][0] = (f32x4){0.f, 0.f, 0.f, 0.f}; ring[k][1] = ring[k][0]; ring[k][2] = ring[k][0];
        const float* up = U + (size_t)(r0 + 16 * k + fr) * 512 + g * 16; if (g4 < 2) { ring[k][0] = *(const f32x4*)(up + 8 * g4); ring[k][1] = *(const f32x4*)(up + 8 * g4 + 4); } if (WRITE) ring[k][2] = *(const f32x4*)(up + 4 * g4); }
    for (int ch0 = 0; ch0 < nch; ch0 += 2) {
#pragma unroll
      for (int k = 0; k < 2; ++k) {
        const int ch = ch0 + k, rr = r0 + 16 * ch;
        const f32x4 u0 = ring[k][0], u1 = ring[k][1], uv = ring[k][2];
        if (ch + 2 < nch) { const float* up = U + (size_t)(rr + 32 + fr) * 512 + g * 16; if (g4 < 2) { ring[k][0] = *(const f32x4*)(up + 8 * g4); ring[k][1] = *(const f32x4*)(up + 8 * g4 + 4); } if (WRITE) ring[k][2] = *(const f32x4*)(up + 4 * g4); }
        bf16x8 uf;
        { u32x4 w; w.x = pk2(u0[0], u0[1]); w.y = pk2(u0[2], u0[3]); w.z = pk2(u1[0], u1[1]); w.w = pk2(u1[2], u1[3]); uf = __builtin_bit_cast(bf16x8, w); }
#pragma unroll
        for (int nb = 0; nb < 8; ++nb) { const f32x4 c = __builtin_amdgcn_mfma_f32_16x16x32_bf16(F.bb[nb], uf, (f32x4){0.f, 0.f, 0.f, 0.f}, 0, 0, 0);
            *(LAS f32x4*)(bu + fr * S5_BU_STR + 16 * nb + 4 * g4) = c; }
        asm volatile("s_waitcnt lgkmcnt(0)" ::: "memory");
        f32x2 bvv[16];
#pragma unroll
        for (int t = 0; t < 16; ++t) bvv[t] = *(const LAS f32x2*)(bu + t * S5_BU_STR + 2 * lane);
#pragma unroll
        for (int t = 0; t < 16; ++t) {
            const float nre = __builtin_fmaf(F.ar, sre, __builtin_fmaf(-F.ai, sim, bvv[t][0])), nim = __builtin_fmaf(F.ar, sim, __builtin_fmaf(F.ai, sre, bvv[t][1])); sre = nre; sim = nim;
            if (WRITE) *(LAS unsigned*)((LAS unsigned char*)hs + t * (S5_HS_STR * 2) + 4 * lane) = pk2(sre, sim);
        }
        asm volatile("s_waitcnt lgkmcnt(0)" ::: "memory");
        if (WRITE) {
            f32x4 y = (f32x4){0.f, 0.f, 0.f, 0.f};
#pragma unroll
            for (int ks = 0; ks < 4; ++ks) { const bf16x8 hf = *(const LAS bf16x8*)((const LAS unsigned char*)hs + fr * (S5_HS_STR * 2) + ks * 64 + g4 * 16);
                y = __builtin_amdgcn_mfma_f32_16x16x32_bf16(F.cc[ks], hf, y, 0, 0, 0); }
            float o[4];
#pragma unroll
            for (int i = 0; i < 4; ++i) { const float v = y[i] + F.dsk[i] * uv[i]; const float z = 1.5957691216057308f * (v + 0.044715f * v * v * v); o[i] = v * frcp(1.0f + fexp2(-z * LOG2E)); }
            u32x2 w; w.x = pk2(o[0], o[1]); w.y = pk2(o[2], o[3]);
            *(LAS u32x2*)(wl + S5_YSTG + (16 * (ch & 7) + fr) * 32 + g4 * 8) = w;
            asm volatile("s_waitcnt lgkmcnt(0)" ::: "memory");
            if ((ch & 7) == 7 || ch == nch - 1) {
                const int nrow = 16 * ((ch & 7) + 1), rb = r0 + 16 * (ch & ~7);
                for (int i = 0; i < nrow; i += 16) { const u32x2 yv = *(const LAS u32x2*)(wl + S5_YSTG + (i + (lane >> 2)) * 32 + (lane & 3) * 8);
                    *(u32x2*)(YACT + (size_t)(rb + i + (lane >> 2)) * 512 + g * 16 + 4 * (lane & 3)) = yv; }
                asm volatile("s_waitcnt lgkmcnt(0)" ::: "memory");
            }
        }
      }
    }
}
__device__ __forceinline__ void s5_prompt_unit(const Args& a, LAS unsigned char* lds, int b, int g) {
    const int tid = threadIdx.x, lane = tid & 63, w = __builtin_amdgcn_readfirstlane(tid >> 6);
    S5Frags F; s5_load_frags(a, g, lane, F);
    LAS unsigned char* wl = lds + w * S5_WAVE_BYTES; LAS float* E = (LAS float*)(lds + 8 * S5_WAVE_BYTES);
    const int r0 = b * SEQ + 256 * w;
    float sre = 0.f, sim = 0.f;
    s5_run<false>(a, F, g, r0, 16, sre, sim, wl, lane);
    E[(w * 64 + lane) * 2] = sre; E[(w * 64 + lane) * 2 + 1] = sim;
    __syncthreads();
    float pr = F.ar, pi = F.ai;
#pragma unroll
    for (int i = 0; i < 8; ++i) { const float nr = pr * pr - pi * pi, ni = 2.f * pr * pi; pr = nr; pi = ni; }
    sre = 0.f; sim = 0.f;
    for (int j = 0; j < w; ++j) { const float er = E[(j * 64 + lane) * 2], ei = E[(j * 64 + lane) * 2 + 1]; const float nr = pr * sre - pi * sim + er, ni = pr * sim + pi * sre + ei; sre = nr; sim = ni; }
    s5_run<true>(a, F, g, r0, 16, sre, sim, wl, lane);
    if (w == 7) { a.out[O_REP + (size_t)(b * 32 + g) * 64 + lane] = sre; a.out[O_IMP + (size_t)(b * 32 + g) * 64 + lane] = sim; }
    __syncthreads();
}
__device__ __forceinline__ void s5_sample_unit(const Args& a, LAS unsigned char* lds, int unit) {
    const int tid = threadIdx.x, lane = tid & 63, w = __builtin_amdgcn_readfirstlane(tid >> 6);
    const int sidx = unit * 8 + w, b = sidx >> 5, g = sidx & 31;
    S5Frags F; s5_load_frags(a, g, lane, F);
    LAS unsigned char* wl = lds + w * S5_WAVE_BYTES;
    float sre = a.in[4][(size_t)(b * 32 + g) * 64 + lane], sim = a.in[5][(size_t)(b * 32 + g) * 64 + lane];
    s5_run<true>(a, F, g, MP + b * 64, 4, sre, sim, wl, lane);
    a.out[O_RES + (size_t)(b * 32 + g) * 64 + lane] = sre; a.out[O_IMS + (size_t)(b * 32 + g) * 64 + lane] = sim;
}


#define GAS __attribute__((address_space(1)))
#define XB_TMO      128
#define XB_XCNT(j)  (256  + 64 * (j))
#define XB_XSUB(j)  (1280 + 64 * (j))
#define XB_XGEN(j)  (2304 + 64 * (j))
#define XB_TOP      3328
#define XB_TOPGEN   3392
#define XCD_BAR_WORDS 3456
#define XB_SPIN_CAP (1u << 18)

__device__ __forceinline__ unsigned xb_ld(unsigned* p)              { return __hip_atomic_load(p, __ATOMIC_RELAXED, __HIP_MEMORY_SCOPE_AGENT); }
__device__ __forceinline__ unsigned xb_add(unsigned* p, unsigned v) { return __hip_atomic_fetch_add(p, v, __ATOMIC_RELAXED, __HIP_MEMORY_SCOPE_AGENT); }
__device__ __forceinline__ unsigned xb_xcc_id() { return (unsigned)__builtin_amdgcn_s_getreg((3 << 11) | 20) & 0xFu; }
#define XB_SPIN(cond, bar) do { unsigned _sp = 0; while (cond) { __builtin_amdgcn_s_sleep(1); \
    if ((++_sp & 255u) == 0u) { if (xb_ld(&(bar)[XB_TMO])) break; if (_sp > XB_SPIN_CAP) { atomicAdd(&(bar)[XB_TMO], 1u); break; } } } } while (0)

struct XcdBarrier {
    unsigned* bar; unsigned x;
    volatile LAS unsigned* st;
};

__device__ __forceinline__ XcdBarrier xcd_barrier_post(unsigned* bar, volatile LAS unsigned* st) {
    XcdBarrier b; b.bar = bar; b.x = xb_xcc_id(); b.st = st;
    if (threadIdx.x == 0) (void)xb_add(&bar[XB_XCNT(b.x)], 1u);
    return b;
}
__device__ __forceinline__ void xcd_barrier_complete(unsigned* bar, unsigned x, unsigned& nloc, unsigned& nx) {
    const unsigned G = gridDim.x * gridDim.y * gridDim.z;
    unsigned sum, cnt, mine, sp = 0u;
    for (;;) {
        sum = 0u; cnt = 0u; mine = 0u;
#pragma unroll
        for (unsigned j = 0; j < 16; ++j) { const unsigned c = xb_ld(&bar[XB_XCNT(j)]); sum += c; cnt += (c > 0u) ? 1u : 0u; mine = (j == x) ? c : mine; }
        if (sum == G) break;
        __builtin_amdgcn_s_sleep(1);
        if ((++sp & 255u) == 0u) { if (xb_ld(&bar[XB_TMO])) break; if (sp > XB_SPIN_CAP) { atomicAdd(&bar[XB_TMO], 1u); break; } }
    }
    nloc = mine > 0u ? mine : 1u; nx = cnt > 0u ? cnt : 1u;
}

__device__ __forceinline__ void xcd_barrier(const XcdBarrier& b) {
    asm volatile("s_waitcnt vmcnt(0)" ::: "memory");
    __syncthreads();
    if (threadIdx.x == 0) {
        unsigned* bar = b.bar;
        __builtin_amdgcn_s_waitcnt(0);
        unsigned nloc = b.st[0], nx = b.st[1];
        if (nloc == 0u) { xcd_barrier_complete(bar, b.x, nloc, nx); b.st[0] = nloc; b.st[1] = nx; }
        const unsigned old = xb_add(&bar[XB_XSUB(b.x)], 1u);
        const unsigned gen = old / nloc;
        if (old + 1u == (gen + 1u) * nloc) {
            __builtin_amdgcn_fence(__ATOMIC_RELEASE, "agent");
            asm volatile("s_waitcnt vmcnt(0)" ::: "memory");
            const unsigned og = xb_add(&bar[XB_TOP], 1u);
            const unsigned tg = og / nx;
            if (og + 1u == (tg + 1u) * nx) xb_add(&bar[XB_TOPGEN], 1u);
            else XB_SPIN(xb_ld(&bar[XB_TOPGEN]) == tg, bar);
            __builtin_amdgcn_fence(__ATOMIC_ACQUIRE, "agent");
            xb_add(&bar[XB_XGEN(b.x)], 1u);
            asm volatile("s_waitcnt vmcnt(0)" ::: "memory");
        } else {
            XB_SPIN(xb_ld(&bar[XB_XGEN(b.x)]) == gen, bar);
            __builtin_amdgcn_fence(__ATOMIC_ACQUIRE, "agent");
            asm volatile("s_waitcnt vmcnt(0)" ::: "memory");
        }
    }
    __syncthreads();
}

constexpr int CV_GU = 16 * 176, CV_D = 44 * 32, CV_IN = 16 * 64, CV_GLU = 8 * 16, CV_SQ = 16 * 32;
constexpr int CV_NA = CV_GU + CV_D + CV_IN + CV_GLU + 3 * CV_SQ, CV_NB = CV_GU + CV_D + 2 * CV_SQ;
__device__ __forceinline__ void conv_item(const Args& a, int it, LAS float* scr, int lane) {
    unsigned char* ws = a.ws; int r = it;
    if (r < CV_GU) { tr_item(a.in[10], 1024, 5632, (bf16_t*)(ws + W_GU1), a.in[9], 1, 0, scr, r, lane); return; } r -= CV_GU;
    if (r < CV_D) { tr_item(a.in[11], 2816, 1024, (bf16_t*)(ws + W_D1), nullptr, 0, 0, scr, r, lane); return; } r -= CV_D;
    if (r < CV_IN) { tr_item(a.in[13], 1024, 2048, (bf16_t*)(ws + W_IN), a.in[12], 0, 0, scr, r, lane); return; } r -= CV_IN;
    if (r < CV_GLU) { tr_item(a.in[22], 512, 512, (bf16_t*)(ws + W_GLU), nullptr, 0, 0, scr, r, lane); return; } r -= CV_GLU;
    if (r < CV_SQ) { tr_item(a.in[27], 1024, 1024, (bf16_t*)(ws + W_OUT), nullptr, 0, 0, scr, r, lane); return; } r -= CV_SQ;
    if (r < CV_SQ) { tr_item(a.in[31], 1024, 1024, (bf16_t*)(ws + W_CKV), a.in[28], 0, 0, scr, r, lane); return; } r -= CV_SQ;
    if (r < CV_SQ) { tr_item(a.in[32], 1024, 1024, (bf16_t*)(ws + W_CKV), a.in[28], 0, 1024, scr, r, lane); return; } r -= CV_SQ;
    if (r < CV_GU) { tr_item(a.in[35], 1024, 5632, (bf16_t*)(ws + W_GU2), a.in[34], 1, 0, scr, r, lane); return; } r -= CV_GU;
    if (r < CV_D) { tr_item(a.in[36], 2816, 1024, (bf16_t*)(ws + W_D2), nullptr, 0, 0, scr, r, lane); return; } r -= CV_D;
    if (r < CV_SQ) { tr_item(a.in[30], 1024, 1024, (bf16_t*)(ws + W_CQ), a.in[29], 0, 0, scr, r, lane); return; } r -= CV_SQ;
    tr_item(a.in[33], 1024, 1024, (bf16_t*)(ws + W_CO), nullptr, 0, 0, scr, r, lane);
}

#ifndef NPH
#define NPH 13
#endif
__global__ void __launch_bounds__(512, 2) mega_fwd(Args a) {
    extern __shared__ __attribute__((aligned(16))) unsigned char lds_raw[];
    LAS unsigned char* lds = (LAS unsigned char*)lds_raw;
    cg::grid_group grid = cg::this_grid();
    const int tid = threadIdx.x, lane = tid & 63, wave = __builtin_amdgcn_readfirstlane(tid >> 6);
    const int G = gridDim.x, c = blockIdx.x;
    const int gw = c * 8 + wave, NGW = G * 8;
    unsigned char* ws = a.ws;
    float* SS = (float*)(ws + W_SSP);
    float* ss1 = SS, *ss2 = SS + (size_t)MT * 16, *ss3 = SS + (size_t)2 * MT * 16, *ss4 = SS + (size_t)3 * MT * 16, *ss5 = SS + (size_t)4 * MT * 16, *ssm = SS + (size_t)5 * MT * 16;
    bf16_t* RB = (bf16_t*)(ws + W_RB); float* R = (float*)(ws + W_R); bf16_t* H = (bf16_t*)(ws + W_H);
#define IN(k) (a.lo <= (k) && (k) < a.hi)
#define SEAM(k) do { if (IN(k) && IN((k) + 1)) xcd_barrier(bar); } while (0)

    volatile LAS unsigned* MISC = (volatile LAS unsigned*)(lds + 147440);
    if (tid < 2) MISC[tid] = 0u;
    __syncthreads();
    XcdBarrier bar = xcd_barrier_post((unsigned*)(ws + W_BAR), MISC);
    if (a.hi < 0) grid.sync();
    if (IN(0)) {
        LAS float* scr = (LAS float*)(lds + wave * 16384);
        const int itEnd = (G == 256) ? CV_NA : CV_NA + CV_NB;
        for (int it = gw; it < itEnd; it += NGW) conv_item(a, it, scr, lane);
        constexpr int NROWS = MT + 2048 + 4096 + 4096;
        for (int r2 = gw; r2 < NROWS / 2; r2 += NGW) {
            const float* src[2]; bf16_t* dst[2]; float* sso[2];
#pragma unroll
            for (int e = 0; e < 2; ++e) { const int r = 2 * r2 + e;
                if (r < MP) { src[e] = a.in[0] + (size_t)r * DM; dst[e] = RB + (size_t)r * DM; sso[e] = ss1 + (size_t)r * 16; }
                else if (r < MT) { src[e] = a.in[1] + (size_t)(r - MP) * DM; dst[e] = RB + (size_t)r * DM; sso[e] = ss1 + (size_t)r * 16; }
                else if (r < MT + 2048) { src[e] = a.in[8] + (size_t)(r - MT) * DM; dst[e] = (bf16_t*)(ws + W_MEMB) + (size_t)(r - MT) * DM; sso[e] = ssm + (size_t)(r - MT) * 16; }
                else if (r < MT + 2048 + 4096) { src[e] = a.in[6] + (size_t)(r - MT - 2048) * DM; dst[e] = (bf16_t*)(ws + W_MK) + (size_t)(r - MT) * DM; sso[e] = nullptr; }
                else { src[e] = a.in[7] + (size_t)(r - MT - 6144) * DM; dst[e] = (bf16_t*)(ws + W_MV) + (size_t)(r - MT - 4096) * DM; sso[e] = nullptr; } }
            f32x4 v[2][4];
#pragma unroll
            for (int e = 0; e < 2; ++e)
#pragma unroll
                for (int j = 0; j < 4; ++j) v[e][j] = ((const f32x4*)src[e] + lane)[64 * j];
#pragma unroll
            for (int e = 0; e < 2; ++e) { float sq = 0.f; const bool isx = (2 * r2 + e) < MT;
#pragma unroll
                for (int j = 0; j < 4; ++j) sq += (v[e][j][0] * v[e][j][0] + v[e][j][1] * v[e][j][1]) + (v[e][j][2] * v[e][j][2] + v[e][j][3] * v[e][j][3]);
                float sc = 1.0f;
                if (sso[e]) { sq = wave_sum(sq); if (lane < 16) sso[e][lane] = lane == 0 ? sq : 0.f; if (isx) sc = rstd_of(sq); }
#pragma unroll
                for (int j = 0; j < 4; ++j) { u32x2 w; w.x = pk2(v[e][j][0] * sc, v[e][j][1] * sc); w.y = pk2(v[e][j][2] * sc, v[e][j][3] * sc); ((u32x2*)dst[e] + lane)[64 * j] = w; } }
        }
        { const int gp = c * 512 + tid;
          if (gp < 2048) { const int g = gp >> 6;
            const float dt = expf(a.in[16][g]), lr = a.in[14][gp], li = a.in[15][gp];
            const float x = lr * dt, y = li * dt, er = expf(x), cy = cosf(y), sy = sinf(y), sh = sinf(0.5f * y);
            const float ar = er * cy, ai = er * sy;
            const float nr = expm1f(x) * cy - 2.f * sh * sh, ni = ai;
            const float den = lr * lr + li * li, fre = (nr * lr + ni * li) / den, fim = (ni * lr - nr * li) / den;
            float* ABAR = (float*)(ws + W_ABAR); float* BBAR = (float*)(ws + W_BBAR);
            ABAR[gp * 2] = ar; ABAR[gp * 2 + 1] = ai;
            const int p = gp & 63;
            for (int h = 0; h < 16; ++h) { const float br = a.in[17][(size_t)gp * 16 + h], bi = a.in[18][(size_t)gp * 16 + h];
                BBAR[((size_t)((g * 2 + 0) * 64 + p)) * 16 + h] = fre * br - fim * bi; BBAR[((size_t)((g * 2 + 1) * 64 + p)) * 16 + h] = fre * bi + fim * br; }
          } }
        if (c == 0 && tid == 0) { float s0 = 0.f, s1 = 0.f; for (int i = 0; i < 64; ++i) { s0 += a.in[24][i] * a.in[25][i]; s1 += a.in[24][64 + i] * a.in[25][64 + i]; }
            *(float*)(ws + W_LAM) = expf(s0) - expf(s1) + LAM_INIT; }
    }
    SEAM(0);
    if (IN(1)) {
        pg8::Gemm g{RB, (const bf16_t*)(ws + W_GU1), MT, 5632, 1024}; pg8::StaticOrder S; S.init(MT, 5632, G, c);
        EpiSwiglu<0> E{nullptr, H};
        pg8::gemm_phase<EpiSwiglu<0>, pg8::StaticOrder, true, true>(lds, g, S, E);
    }
    SEAM(1);
    if (IN(2)) {
        pg8::Gemm g{H, (const bf16_t*)(ws + W_D1), MP, 1024, 2816}; pg8::StaticOrder S; S.init(MP, 1024, G, c);
        EpiResid2 E{EpiResid{a.in[0], nullptr, RB, ss2, 0.5f}, EpiResid{a.in[1] - (size_t)MP * DM, nullptr, RB, ss2, 0.5f}};
        pg8::gemm_phase<EpiResid2, pg8::StaticOrder, true, true>(lds, g, S, E);
        for (int u = c; u < 256; u += G) mini_gemm(lds, H, (const bf16_t*)(ws + W_D1), 2816, MP + 64 * (u >> 4), 64 * (u & 15), E.s);
    }
    SEAM(2);
    if (IN(3)) {
        { pg8::Gemm g{RB, (const bf16_t*)(ws + W_IN), MP, 2048, 1024}; pg8::StaticOrder S; S.init(MP, 2048, G, c);
          LAS float* rl = (LAS float*)(lds + 131072);
          { pg8::Unit uu; for (int i = 0; i < 16 && S.next(i, uu); ++i) if (tid < 256) rl[256 * i + tid] = rstd_row(ss2, uu.pm * 256 + tid); }
          __syncthreads();
          EpiInproj E{ss2, (float*)(ws + W_U), (bf16_t*)(ws + W_QB), (bf16_t*)(ws + W_KB), (bf16_t*)(ws + W_VB), a.out, rl};
          pg8::gemm_phase<EpiInproj, pg8::StaticOrder, true, true>(lds, g, S, E);
          for (int u = c; u < 512; u += G) mini_gemm(lds, RB, (const bf16_t*)(ws + W_IN), 1024, MP + 64 * (u >> 5), 64 * (u & 31), E); }
    }
    SEAM(3);
    if (IN(4)) {
        const bool sample_first = ((c >> 3) & 1) == 0;
        if (sample_first) for (int sid = c; sid < 256; sid += G) { const int bh = sid >> 2; diff_sample_unit(a, lds, bh >> 2, bh & 3, sid & 3); }
        for (int u = c; u < 256; u += G) s5_prompt_unit(a, lds, u >> 5, u & 31);
        for (int u = c; u < 256; u += G) if ((u & 3) == 0) s5_sample_unit(a, lds, u >> 2);
        __syncthreads();
        const float lam = *(const float*)(ws + W_LAM);
        if (G == 256) {
            const int j = c >> 3, bh = 4 * (c & 7) + (j >> 3), cp = j & 7;
            diff_prompt_unit(a, lds, bh >> 2, bh & 3, 15 - cp, lam); diff_prompt_unit(a, lds, bh >> 2, bh & 3, cp, lam);
        } else
        for (int pid = c; pid < 256; pid += G) { const int bh = pid >> 3, cp = pid & 7;
            diff_prompt_unit(a, lds, bh >> 2, bh & 3, 15 - cp, lam); diff_prompt_unit(a, lds, bh >> 2, bh & 3, cp, lam); }
        if (!sample_first) for (int sid = c; sid < 256; sid += G) { const int bh = sid >> 2; diff_sample_unit(a, lds, bh >> 2, bh & 3, sid & 3); }
    }
    SEAM(4);
    if (IN(5)) {
        const float lam = *(const float*)(ws + W_LAM);
        const float* P = (const float*)(ws + W_PART); const float* ML = (const float*)(ws + W_ML); bf16_t* CAT = (bf16_t*)(ws + W_CAT);
        for (int idx = gw; idx < 4096; idx += NGW) {
            const int bh = idx >> 6, q = idx & 63; float on[2][2];
#pragma unroll
            for (int map = 0; map < 2; ++map) {
                float mm[4], ll[4]; float M = -INFINITY;
#pragma unroll
                for (int sp = 0; sp < 4; ++sp) { const int pi = ((bh * 4 + sp) * 2 + map) * 64 + q; mm[sp] = ML[pi * 2]; ll[sp] = ML[pi * 2 + 1]; M = __builtin_fmaxf(M, mm[sp]); }
                float Lt = 0.f, o0 = 0.f, o1 = 0.f;
#pragma unroll
                for (int sp = 0; sp < 4; ++sp) { const int pi = ((bh * 4 + sp) * 2 + map) * 64 + q; const float wgt = fexp2(mm[sp] - M); Lt += wgt * ll[sp];
                    const f32x2 pv = *(const f32x2*)(P + (size_t)pi * 128 + 2 * lane); o0 += wgt * pv[0]; o1 += wgt * pv[1]; }
                on[map][0] = o0 / Lt; on[map][1] = o1 / Lt;
            }
            const float d0 = on[0][0] - lam * on[1][0], d1 = on[0][1] - lam * on[1][1];
            const float ss = wave_sum(d0 * d0 + d1 * d1); const float rn = (1.0f - LAM_INIT) / sqrtf(ss * (1.0f / 128.0f) + EPS);
            const int b = bh >> 2, h = bh & 3;
            *(unsigned*)(CAT + (size_t)(MP + b * 64 + q) * DM + 512 + h * 128 + 2 * lane) = pk2(d0 * rn * a.in[26][2 * lane], d1 * rn * a.in[26][2 * lane + 1]);
        }
        pg8::Gemm g{(const bf16_t*)(ws + W_YACT), (const bf16_t*)(ws + W_GLU), MT, 512, 512}; pg8::StaticOrder S; S.init(MT, 512, G, c);
        EpiGlu E{(const bf16_t*)(ws + W_YACT), a.in[23], CAT};
        pg8::gemm_phase<EpiGlu, pg8::StaticOrder, true, true>(lds, g, S, E);
        { pg8::Gemm g2{(const bf16_t*)(ws + W_MEMB), (const bf16_t*)(ws + W_CKV), 2048, 2048, 1024}; pg8::StaticOrder S2; S2.init(2048, 2048, G, (c + G - 136) % G);
          EpiMem E2{ssm, a.out, (bf16_t*)(ws + W_MK), (bf16_t*)(ws + W_MV)};
          pg8::gemm_phase<EpiMem, pg8::StaticOrder, true, true>(lds, g2, S2, E2); }
        if (G == 256 && (c < 136 || c >= 200)) {
            LAS float* scr = (LAS float*)(lds + wave * 16384);
            const int wv = (c < 136 ? c : c - 64) * 8 + wave;
            for (int it = CV_NA + wv; it < CV_NA + CV_NB; it += 192 * 8) conv_item(a, it, scr, lane);
        }
    }
    SEAM(5);
    if (IN(6)) {
        pg8::Gemm g{(const bf16_t*)(ws + W_CAT), (const bf16_t*)(ws + W_OUT), MP, 1024, 1024}; pg8::StaticOrder S; S.init(MP, 1024, G, c);
        EpiResid E{nullptr, RB, RB, ss3, 1.0f};
        pg8::gemm_phase<EpiResid, pg8::StaticOrder, true, true>(lds, g, S, E);
        for (int u = c; u < 256; u += G) mini_gemm(lds, (const bf16_t*)(ws + W_CAT), (const bf16_t*)(ws + W_OUT), 1024, MP + 64 * (u >> 4), 64 * (u & 15), E);
    }
    SEAM(6);
    if (IN(7)) {
        pg8::Gemm g{RB, (const bf16_t*)(ws + W_CQ), MP, 1024, 1024}; pg8::StaticOrder S; S.init(MP, 1024, G, c);
        EpiScaleBf16 E{ss3, (bf16_t*)(ws + W_QC), QS_CROSS};
        pg8::gemm_phase<EpiScaleBf16, pg8::StaticOrder, true, true>(lds, g, S, E);
        for (int u = c; u < 256; u += G) mini_gemm(lds, RB, (const bf16_t*)(ws + W_CQ), 1024, MP + 64 * (u >> 4), 64 * (u & 15), E);
    }
    SEAM(7);
    if (IN(8)) {
        if (G == 256) {
            for (int i = 0; i < 2; ++i) { const int item = (c >> 3) + 32 * i, bh = 4 * (c & 7) + (item >> 4); cross_unit(a, lds, bh >> 2, bh & 3, item & 15); }
            if (c < 64) cross_unit(a, lds, 8 + (c >> 2), c & 3, 0);
        } else
        for (int u = c; u < 576; u += G) {
            if (u < 512) cross_unit(a, lds, u >> 6, (u >> 4) & 3, u & 15);
            else { const int v = u - 512; cross_unit(a, lds, 8 + (v >> 2), v & 3, 0); }
        }
    }
    SEAM(8);
    if (IN(9)) {
        pg8::Gemm g{(const bf16_t*)(ws + W_OC), (const bf16_t*)(ws + W_CO), MP, 1024, 1024}; pg8::StaticOrder S; S.init(MP, 1024, G, c);
        EpiResid E{nullptr, RB, RB, ss4, 1.0f};
        pg8::gemm_phase<EpiResid, pg8::StaticOrder, true, true>(lds, g, S, E);
        for (int u = c; u < 256; u += G) mini_gemm(lds, (const bf16_t*)(ws + W_OC), (const bf16_t*)(ws + W_CO), 1024, MP + 64 * (u >> 4), 64 * (u & 15), E);
    }
    SEAM(9);
    if (IN(10)) {
        pg8::Gemm g{RB, (const bf16_t*)(ws + W_GU2), MT, 5632, 1024}; pg8::StaticOrder S; S.init(MT, 5632, G, c);
        LAS float* rl = (LAS float*)(lds + 131072);
        { pg8::Unit uu; for (int i = 0; i < 16 && S.next(i, uu); ++i) if (tid < 256) rl[256 * i + tid] = rstd_row(ss4, uu.pm * 256 + tid); }
        __syncthreads();
        EpiSwiglu<2> E{rl, H};
        pg8::gemm_phase<EpiSwiglu<2>, pg8::StaticOrder, true, true>(lds, g, S, E);
    }
    SEAM(10);
    if (IN(11)) {
        pg8::Gemm g{H, (const bf16_t*)(ws + W_D2), MP, 1024, 2816}; pg8::StaticOrder S; S.init(MP, 1024, G, c);
        EpiResid E{nullptr, RB, RB, ss5, 0.5f};
        pg8::gemm_phase<EpiResid, pg8::StaticOrder, true, true>(lds, g, S, E);
        for (int u = c; u < 256; u += G) mini_gemm(lds, H, (const bf16_t*)(ws + W_D2), 2816, MP + 64 * (u >> 4), 64 * (u & 15), E);
    }
    SEAM(11);
    if (IN(12)) {
#pragma unroll 2
        for (int r = gw; r < MT; r += NGW) {
            const float rs = rstd_row(ss5, r); const u32x4* xr = (const u32x4*)(RB + (size_t)r * DM) + lane; const f32x4* gr = (const f32x4*)a.in[37]; f32x4* o = (f32x4*)(a.out + O_Y + (size_t)r * DM);
#pragma unroll
            for (int j = 0; j < 2; ++j) { const u32x4 t = xr[64 * j]; const int c8 = (64 * j + lane) * 2;
                const f32x4 x0 = (f32x4){__builtin_bit_cast(float, t.x << 16), __builtin_bit_cast(float, t.x & 0xffff0000u), __builtin_bit_cast(float, t.y << 16), __builtin_bit_cast(float, t.y & 0xffff0000u)};
                const f32x4 x1 = (f32x4){__builtin_bit_cast(float, t.z << 16), __builtin_bit_cast(float, t.z & 0xffff0000u), __builtin_bit_cast(float, t.w << 16), __builtin_bit_cast(float, t.w & 0xffff0000u)};
                o[c8] = x0 * gr[c8] * rs; o[c8 + 1] = x1 * gr[c8 + 1] * rs; }
        }
    }
#undef IN
#undef SEAM
}

extern "C" void kernel_launch(void* const* d_in, const int* in_sizes, int n_in, void* d_out, int out_size, void* d_ws, size_t ws_size, hipStream_t stream) {
    static int grid = 0;
    if (grid == 0) {
        if (n_in != 38 || (size_t)out_size != O_TOTAL || ws_size < W_END) { fprintf(stderr, "kernel_launch: unexpected shapes: n_in %d out %d ws %zu\n", n_in, out_size, ws_size); grid = -1; return; }
        int dev = 0, cus = 0, per_cu = 0;
        (void)hipGetDevice(&dev); (void)hipDeviceGetAttribute(&cus, hipDeviceAttributeMultiprocessorCount, dev);
        (void)hipFuncSetAttribute((const void*)mega_fwd, hipFuncAttributeMaxDynamicSharedMemorySize, LDS_BYTES);
        (void)hipOccupancyMaxActiveBlocksPerMultiprocessor(&per_cu, (const void*)mega_fwd, 512, LDS_BYTES);
        (void)hipGetLastError();
        if (per_cu < 1) fprintf(stderr, "kernel_launch: occupancy query says %d blocks per CU\n", per_cu);
        grid = cus > 0 ? cus : 256;
    }
    if (grid < 0) return;
    (void)hipMemsetAsync((char*)d_ws + W_BAR, 0, 16384, stream);
    Args a{};
    for (int i = 0; i < 38; ++i) a.in[i] = (const float*)d_in[i];
    a.out = (float*)d_out; a.ws = (unsigned char*)d_ws; a.lo = 0; a.hi = NPH;
    void* args[] = {&a};
    hipError_t e = hipLaunchCooperativeKernel((const void*)mega_fwd, dim3(grid), dim3(512), args, LDS_BYTES, stream);
    if (e != hipSuccess) fprintf(stderr, "cooperative launch failed: %s (grid %d)\n", hipGetErrorString(e), grid);
}
```

```cpp
#include <hip/hip_runtime.h>
#include <hip/hip_cooperative_groups.h>
#include <cstdio>
#include <cstdint>
#include <cmath>
namespace cg = cooperative_groups;
namespace pg8 {
#define PG8_LAS __attribute__((address_space(3)))
typedef unsigned short bf16_t;
typedef short bf16x8 __attribute__((ext_vector_type(8)));
typedef float f32x4 __attribute__((ext_vector_type(4)));
typedef unsigned u32x4 __attribute__((ext_vector_type(4)));
constexpr int BM = 256, BK = 64, HALF = 128, HTB = HALF * BK * 2  , STAGE_BYTES = 8 * HTB, NXCD = 8, WGM = 8;

__host__ __device__ __forceinline__ int lds_byte(int r, int c) { const int st = (r >> 4) * 2 + (c >> 5), rr = r & 15, cc = c & 31, ob = rr * 64 + cc * 2; return st * 1024 + (ob ^ (((ob >> 9) & 1) << 5)); }
__host__ __device__ __forceinline__ void stage_rc(int b, int& R, int& C) { const int st = b / 1024, sb = b % 1024, swz = sb ^ (((sb >> 9) & 1) << 5); R = (st >> 1) * 16 + swz / 64; C = (st & 1) * 32 + (swz % 64) / 2; }
__host__ __device__ __forceinline__ int perm32(int rho) { const int n = rho >> 4, i = rho & 15; return 8 * (i >> 2) + 4 * n + (i & 3); }

struct Unit { int pm, pn; };
struct Gemm { const bf16_t* A; const bf16_t* Bt; int M, N, K; };

struct StaticOrder {
    int nM, nN, nwg, G, c;
    __host__ __device__ void init(int M, int N, int G_, int c_) { nM = M / BM; nN = N / BM; nwg = nM * nN; G = G_; c = c_; }
    __host__ __device__ __forceinline__ bool next(int i, Unit& u) const {
        const long L = (long)i * G + c; if (L >= nwg) return false;
        int wgid = (int)L; { const int q = nwg / NXCD, r = nwg % NXCD, xcd = wgid % NXCD, off = wgid / NXCD; wgid = (xcd < r ? xcd * (q + 1) : r * (q + 1) + (xcd - r) * q) + off; }
        const int nig = WGM * nN, gid = wgid / nig, fm = gid * WGM, gsz = (nM - fm) < WGM ? (nM - fm) : WGM;
        u.pm = fm + ((wgid % nig) % gsz); u.pn = (wgid % nig) / gsz; return true;
    }
    __device__ __forceinline__ void a_ready(const Unit&) const {}
    __device__ __forceinline__ void done(const Unit&) const {}
};

__device__ __forceinline__ unsigned cvt_pk_bf16(float lo, float hi) { unsigned r; asm volatile("v_cvt_pk_bf16_f32 %0, %1, %2" : "=v"(r) : "v"(lo), "v"(hi)); return r; }
template <class Epi, class Sched, bool ALIGN_EPI = false, bool SP2 = false>
__device__ __forceinline__ void gemm_phase(PG8_LAS unsigned char* lds, const Gemm g, const Sched& S, const Epi& E) {
    const int tid = threadIdx.x, wid = __builtin_amdgcn_readfirstlane(tid >> 6), lane = tid & 63, wr = wid >> 2, wc = wid & 3, fr = lane & 15, fq = lane >> 4;
    const int K = g.K, nt = K / BK;
    unsigned voffA[2], voffB[2];
#pragma unroll
    for (int i = 0; i < 2; ++i) { int R, C; stage_rc(tid * 16 + i * 8192, R, C); const int Rb = Epi::PERM ? ((R & ~31) + perm32(R & 31)) : R;
        voffA[i] = (unsigned)(R * K + C) * 2u; voffB[i] = (unsigned)(Rb * K + C) * 2u; }
    const size_t kstep = (size_t)(BK * 2);
    const size_t hstep = (size_t)HALF * K * 2;
    const size_t tstep = 2 * hstep;
    const unsigned ldsw = (unsigned)wid * 1024u;
    const int aoff = lds_byte(wr * 64 + fr, fq * 8), boff = lds_byte(wc * 32 + fr, fq * 8);
#define PG8_SA(b, h) (((b) * 2 + (h)) * HTB)
#define PG8_SB(b, h) ((4 + (b) * 2 + (h)) * HTB)
#define PG8_STAGE(bufoff, gbase, voff) do { _Pragma("unroll") for (int _i = 0; _i < 2; ++_i) \
        __builtin_amdgcn_global_load_lds((const unsigned*)((const char*)(gbase) + (voff)[_i]), (PG8_LAS unsigned*)(lds + (bufoff) + ldsw + _i * 8192), 16, 0, 0); } while (0)
#define PG8_LDA(dst, b, h) do { _Pragma("unroll") for (int m = 0; m < 4; ++m) _Pragma("unroll") for (int k = 0; k < 2; ++k) dst[m][k] = *(const PG8_LAS bf16x8*)(lds + PG8_SA(b, h) + aoff + m * 2048 + k * 1024); } while (0)
#define PG8_LDB(dst, b, h) do { _Pragma("unroll") for (int n = 0; n < 2; ++n) _Pragma("unroll") for (int k = 0; k < 2; ++k) dst[n][k] = *(const PG8_LAS bf16x8*)(lds + PG8_SB(b, h) + boff + n * 2048 + k * 1024); } while (0)
#define PG8_MMA(ai, bj, At, Bt) do { __builtin_amdgcn_s_setprio(1); _Pragma("unroll") for (int m = 0; m < 4; ++m) _Pragma("unroll") for (int n = 0; n < 2; ++n) _Pragma("unroll") for (int k = 0; k < 2; ++k) \
        acc[ai][bj][m][n] = __builtin_amdgcn_mfma_f32_16x16x32_bf16(Bt[n][k], At[m][k], acc[ai][bj][m][n], 0, 0, 0); __builtin_amdgcn_s_setprio(0); } while (0)
#define PG8_WAIT_V(n) asm volatile("s_waitcnt vmcnt(" #n ")" ::: "memory")
#define PG8_WAIT_L(n) asm volatile("s_waitcnt lgkmcnt(" #n ")" ::: "memory")
#define PG8_BAR __builtin_amdgcn_s_barrier()
#define PG8_SCHED __builtin_amdgcn_sched_barrier(0)
    Unit cur, nxt; int ui = 0;
    if (!S.next(0, cur)) return;
    f32x4 acc[2][2][4][2];
#pragma unroll
    for (int a = 0; a < 2; ++a)
#pragma unroll
        for (int b = 0; b < 2; ++b)
#pragma unroll
            for (int m = 0; m < 4; ++m)
#pragma unroll
                for (int n = 0; n < 2; ++n) acc[a][b][m][n] = (f32x4){0.f, 0.f, 0.f, 0.f};
    bf16x8 At[4][2], B0[2][2], B1[2][2];
    const char* cA = (const char*)g.A + (size_t)cur.pm * tstep; const char* cB = (const char*)g.Bt + (size_t)cur.pn * tstep;
    S.a_ready(cur);
    if constexpr (SP2) {
        PG8_STAGE(PG8_SB(0, 0), cB, voffB); PG8_STAGE(PG8_SB(0, 1), cB + hstep, voffB); PG8_STAGE(PG8_SA(0, 0), cA, voffA); PG8_STAGE(PG8_SA(0, 1), cA + hstep, voffA);
        if (wr == 1) PG8_BAR;
        PG8_WAIT_V(2); PG8_BAR;
        PG8_STAGE(PG8_SB(1, 0), cB + kstep, voffB); PG8_STAGE(PG8_SA(1, 0), cA + kstep, voffA); PG8_STAGE(PG8_SB(1, 1), cB + hstep + kstep, voffB);
        PG8_WAIT_V(6); PG8_BAR;
    } else {
        PG8_STAGE(PG8_SB(0, 0), cB, voffB); PG8_STAGE(PG8_SA(0, 0), cA, voffA); PG8_STAGE(PG8_SB(0, 1), cB + hstep, voffB); PG8_STAGE(PG8_SA(0, 1), cA + hstep, voffA);
        if (wr == 1) PG8_BAR;
        PG8_WAIT_V(4); PG8_BAR;
        PG8_STAGE(PG8_SB(1, 0), cB + kstep, voffB); PG8_STAGE(PG8_SA(1, 0), cA + kstep, voffA); PG8_STAGE(PG8_SB(1, 1), cB + hstep + kstep, voffB);
        PG8_WAIT_V(6); PG8_BAR;
    }
    for (;;) {
        const bool has_next = S.next(ui + 1, nxt);
        const char* nA = has_next ? (const char*)g.A + (size_t)nxt.pm * tstep : cA; const char* nB = has_next ? (const char*)g.Bt + (size_t)nxt.pn * tstep : cB;
        for (int t = 0; t < nt; t += 2) {
            const bool last = (t == nt - 2);
            const char* a1 = cA + (size_t)(t + 1) * kstep;
            const char* a2 = last ? nA : cA + (size_t)(t + 2) * kstep; const char* b2 = last ? nB : cB + (size_t)(t + 2) * kstep;
            const char* a3 = a2 + kstep; const char* b3 = b2 + kstep;
            if (last && has_next) S.a_ready(nxt);
            if constexpr (SP2) {
            PG8_LDB(B0, 0, 0); PG8_LDB(B1, 0, 1); PG8_SCHED; PG8_LDA(At, 0, 0); PG8_STAGE(PG8_SA(1, 1), a1 + hstep, voffA);
            PG8_WAIT_V(8); PG8_WAIT_L(0); PG8_BAR; PG8_MMA(0, 0, At, B0); PG8_MMA(0, 1, At, B1); PG8_BAR; PG8_SCHED;
            PG8_LDA(At, 0, 1); PG8_STAGE(PG8_SB(0, 0), b2, voffB); PG8_STAGE(PG8_SB(0, 1), b2 + hstep, voffB); PG8_STAGE(PG8_SA(0, 0), a2, voffA);
            PG8_WAIT_V(8); PG8_WAIT_L(0); PG8_BAR; PG8_MMA(1, 0, At, B0); PG8_MMA(1, 1, At, B1); PG8_BAR; PG8_SCHED;
            PG8_LDB(B0, 1, 0); PG8_LDB(B1, 1, 1); PG8_SCHED; PG8_LDA(At, 1, 0); PG8_STAGE(PG8_SA(0, 1), a2 + hstep, voffA);
            PG8_WAIT_V(8); PG8_WAIT_L(0); PG8_BAR; PG8_MMA(0, 0, At, B0); PG8_MMA(0, 1, At, B1); PG8_BAR; PG8_SCHED;
            PG8_LDA(At, 1, 1); PG8_STAGE(PG8_SB(1, 0), b3, voffB); PG8_STAGE(PG8_SB(1, 1), b3 + hstep, voffB); PG8_STAGE(PG8_SA(1, 0), a3, voffA);
            PG8_WAIT_V(8); PG8_WAIT_L(0); PG8_BAR; PG8_MMA(1, 0, At, B0); PG8_MMA(1, 1, At, B1); PG8_BAR; PG8_SCHED;
            } else {
            PG8_LDB(B0, 0, 0); PG8_SCHED; PG8_LDA(At, 0, 0); PG8_STAGE(PG8_SA(1, 1), a1 + hstep, voffA);
            PG8_WAIT_L(8); PG8_BAR; PG8_WAIT_L(0); PG8_MMA(0, 0, At, B0); PG8_BAR; PG8_SCHED;
            PG8_LDB(B1, 0, 1); PG8_STAGE(PG8_SB(0, 0), b2, voffB);
            PG8_BAR; PG8_WAIT_L(0); PG8_MMA(0, 1, At, B1); PG8_BAR;
            PG8_LDA(At, 0, 1); PG8_STAGE(PG8_SA(0, 0), a2, voffA);
            PG8_BAR; PG8_WAIT_L(0); PG8_MMA(1, 0, At, B0); PG8_BAR; PG8_SCHED;
            PG8_STAGE(PG8_SB(0, 1), b2 + hstep, voffB);
            PG8_WAIT_V(6); PG8_BAR; PG8_MMA(1, 1, At, B1); PG8_BAR;
            PG8_LDB(B0, 1, 0); PG8_SCHED; PG8_LDA(At, 1, 0); PG8_STAGE(PG8_SA(0, 1), a2 + hstep, voffA);
            PG8_WAIT_L(8); PG8_BAR; PG8_WAIT_L(0); PG8_MMA(0, 0, At, B0); PG8_BAR; PG8_SCHED;
            PG8_LDB(B1, 1, 1); PG8_STAGE(PG8_SB(1, 0), b3, voffB);
            PG8_BAR; PG8_WAIT_L(0); PG8_MMA(0, 1, At, B1); PG8_BAR;
            PG8_LDA(At, 1, 1); PG8_STAGE(PG8_SA(1, 0), a3, voffA);
            PG8_BAR; PG8_WAIT_L(0); PG8_MMA(1, 0, At, B0); PG8_BAR; PG8_SCHED;
            PG8_STAGE(PG8_SB(1, 1), b3 + hstep, voffB);
            PG8_WAIT_V(6); PG8_BAR; PG8_MMA(1, 1, At, B1); PG8_BAR;
            }
        }
        if constexpr (ALIGN_EPI) { if (wr == 0) PG8_BAR; }
        if constexpr (!Epi::AFTER_DRAIN) { E(acc, cur, wr, wc, fr, fq, ui); S.done(cur); }
        if (!has_next) break;
#pragma unroll
        for (int a = 0; a < 2; ++a)
#pragma unroll
            for (int b = 0; b < 2; ++b)
#pragma unroll
                for (int m = 0; m < 4; ++m)
#pragma unroll
                    for (int n = 0; n < 2; ++n) acc[a][b][m][n] = (f32x4){0.f, 0.f, 0.f, 0.f};
        cur = nxt; cA = nA; cB = nB; ++ui;
        if constexpr (ALIGN_EPI) { if (wr == 1) PG8_BAR; }
    }
    PG8_WAIT_V(0);
    if constexpr (!ALIGN_EPI) { if (wr == 0) PG8_BAR; }
    PG8_BAR;
    if constexpr (Epi::AFTER_DRAIN) { E.fused(acc, cur, wr, wc, fr, fq, lds, wid, lane); S.done(cur); }
#undef PG8_SA
#undef PG8_SB
#undef PG8_STAGE
#undef PG8_LDA
#undef PG8_LDB
#undef PG8_MMA
#undef PG8_WAIT_V
#undef PG8_WAIT_L
#undef PG8_BAR
#undef PG8_SCHED
}
}

#define LAS __attribute__((address_space(3)))
typedef unsigned short bf16_t;
typedef short bf16x8 __attribute__((ext_vector_type(8)));
typedef short s16x4 __attribute__((ext_vector_type(4)));
typedef float f32x4 __attribute__((ext_vector_type(4)));
typedef float f32x2 __attribute__((ext_vector_type(2)));
typedef unsigned u32x4 __attribute__((ext_vector_type(4)));
typedef unsigned u32x2 __attribute__((ext_vector_type(2)));
typedef __bf16 bf16x2_t __attribute__((ext_vector_type(2)));

constexpr int MP = 16384, MS = 1024, MT = MP + MS;
constexpr int DM = 1024, DFF = 2816, SEQ = 2048, PAST = 4096;
constexpr float EPS = 1e-6f;
constexpr float LOG2E = 1.4426950408889634f;
constexpr float QS_DIFF = 0.125f * LOG2E, QS_CROSS = 0.0625f * LOG2E;
constexpr float LAM_INIT = 0.2f;

constexpr size_t O_Y = 0, O_KP = 17825792, O_VP = 26214400, O_REP = 34603008, O_IMP = 34619392, O_MKP = 34635776, O_MVP = 36732928,
                 O_KS = 38830080, O_VS = 39354368, O_RES = 39878656, O_IMS = 39911424, O_TOTAL = 39944192;
constexpr size_t MiB = 1u << 20;
constexpr size_t W_SS = 0;
constexpr size_t W_SSM = 348160, W_ABAR = 356352, W_BBAR = 372736, W_LAM = 634880;
constexpr size_t W_GU1 = 1 * MiB, W_D1 = 12 * MiB, W_IN = 18 * MiB, W_GLU = 22 * MiB, W_OUT = 23 * MiB, W_CQ = 25 * MiB, W_CKV = 27 * MiB, W_CO = 31 * MiB,
                 W_GU2 = 33 * MiB, W_D2 = 44 * MiB;
constexpr size_t W_RB = 50 * MiB, W_R = 84 * MiB, W_H = 152 * MiB, W_QC = 152 * MiB, W_OC = 186 * MiB, W_U = 246 * MiB, W_QB = 280 * MiB, W_KB = 297 * MiB,
                 W_VB = 314 * MiB, W_YACT = 331 * MiB, W_CAT = 348 * MiB, W_MEMB = 382 * MiB, W_MK = 386 * MiB, W_MV = 398 * MiB, W_PART = 410 * MiB,
                 W_ML = 426 * MiB, W_SSP = 427 * MiB, W_END = 434 * MiB;
constexpr size_t W_BAR = 655360;
constexpr int LDS_BYTES = 147456;

struct Args { const float* in[38]; float* out; unsigned char* ws; int lo, hi; };

__device__ __forceinline__ unsigned pk2(float lo, float hi) { f32x2 v = {lo, hi}; bf16x2_t b = __builtin_convertvector(v, bf16x2_t); return __builtin_bit_cast(unsigned, b); }
__device__ __forceinline__ float bf2f(bf16_t v) { return __builtin_bit_cast(float, (unsigned)v << 16); }
__device__ __forceinline__ float wave_sum(float v) {
#pragma unroll
    for (int o = 1; o < 64; o <<= 1) v += __shfl_xor(v, o);
    return v;
}
__device__ __forceinline__ float fexp2(float x) { return __builtin_amdgcn_exp2f(x); }
__device__ __forceinline__ float frcp(float x) { return __builtin_amdgcn_rcpf(x); }
__device__ __forceinline__ float rstd_of(float ss) { return 1.0f / sqrtf(ss * (1.0f / 1024.0f) + EPS); }
__device__ __forceinline__ float rstd_row(const float* ssp, int row) { const f32x4* q = (const f32x4*)(ssp + (size_t)row * 16); const f32x4 t = (q[0] + q[1]) + (q[2] + q[3]); return rstd_of((t[0] + t[1]) + (t[2] + t[3])); }

using pg8::Unit;
template <int SCALE> struct EpiSwiglu {
    static constexpr bool PERM = true, AFTER_DRAIN = false;
    const LAS float* rl; bf16_t* H;
    __device__ __forceinline__ void operator()(const f32x4 (&acc)[2][2][4][2], const Unit& u, int wr, int wc, int fr, int fq, int ui) const {
#pragma unroll
        for (int ai = 0; ai < 2; ++ai)
#pragma unroll
            for (int m = 0; m < 4; ++m) {
                const int row = u.pm * 256 + ai * 128 + wr * 64 + m * 16 + fr; float rs = 1.0f; if constexpr (SCALE == 2) rs = rl[256 * ui + ai * 128 + wr * 64 + m * 16 + fr]; float h[8];
#pragma unroll
                for (int n = 0; n < 2; ++n) {
                    const f32x4 g = acc[ai][0][m][n] * rs, up = acc[ai][1][m][n] * rs;
#pragma unroll
                    for (int i = 0; i < 4; ++i) h[4 * n + i] = g[i] * frcp(1.0f + fexp2(-g[i] * LOG2E)) * up[i];
                }
                u32x4 w; w.x = pk2(h[0], h[1]); w.y = pk2(h[2], h[3]); w.z = pk2(h[4], h[5]); w.w = pk2(h[6], h[7]);
                *(u32x4*)(H + (size_t)row * DFF + u.pn * 128 + wc * 32 + fq * 8) = w;
            }
    }
};
struct EpiResid {
    static constexpr bool PERM = true, AFTER_DRAIN = false;
    const float* Rin32; const bf16_t* Rin16; bf16_t* Rb; float* ssout; float alpha;
    __device__ __forceinline__ void operator()(const f32x4 (&acc)[2][2][4][2], const Unit& u, int wr, int wc, int fr, int fq, int ui) const {
#pragma unroll
        for (int ai = 0; ai < 2; ++ai) {
            f32x4 pre[4][2][2];
#pragma unroll
            for (int m = 0; m < 4; ++m) { const int row = u.pm * 256 + ai * 128 + wr * 64 + m * 16 + fr;
#pragma unroll
                for (int bj = 0; bj < 2; ++bj) { const size_t off = (size_t)row * DM + u.pn * 256 + bj * 128 + wc * 32 + fq * 8;
                    if (Rin32) { pre[m][bj][0] = *(const f32x4*)(Rin32 + off); pre[m][bj][1] = *(const f32x4*)(Rin32 + off + 4); }
                    else { const u32x4 t = *(const u32x4*)(Rin16 + off);
                        pre[m][bj][0] = (f32x4){__builtin_bit_cast(float, t.x << 16), __builtin_bit_cast(float, t.x & 0xffff0000u), __builtin_bit_cast(float, t.y << 16), __builtin_bit_cast(float, t.y & 0xffff0000u)};
                        pre[m][bj][1] = (f32x4){__builtin_bit_cast(float, t.z << 16), __builtin_bit_cast(float, t.z & 0xffff0000u), __builtin_bit_cast(float, t.w << 16), __builtin_bit_cast(float, t.w & 0xffff0000u)}; } } }
#pragma unroll
            for (int m = 0; m < 4; ++m) {
                const int row = u.pm * 256 + ai * 128 + wr * 64 + m * 16 + fr; float sq = 0.f;
#pragma unroll
                for (int bj = 0; bj < 2; ++bj) {
                    const size_t off = (size_t)row * DM + u.pn * 256 + bj * 128 + wc * 32 + fq * 8;
                    const f32x4 o0 = pre[m][bj][0] + acc[ai][bj][m][0] * alpha, o1 = pre[m][bj][1] + acc[ai][bj][m][1] * alpha;
                    sq += ((o0[0] * o0[0] + o0[1] * o0[1]) + (o0[2] * o0[2] + o0[3] * o0[3])) + ((o1[0] * o1[0] + o1[1] * o1[1]) + (o1[2] * o1[2] + o1[3] * o1[3]));
                    u32x4 w; w.x = pk2(o0[0], o0[1]); w.y = pk2(o0[2], o0[3]); w.z = pk2(o1[0], o1[1]); w.w = pk2(o1[2], o1[3]); *(u32x4*)(Rb + off) = w;
                }
                sq += __shfl_xor(sq, 16); sq += __shfl_xor(sq, 32);
                if (fq == 0) ssout[(size_t)row * 16 + u.pn * 4 + wc] = sq;
            }
        }
    }
    struct Pre { f32x4 f[2]; u32x2 h[2]; };
    __device__ __forceinline__ Pre mini_pre(int row, int col) const { Pre p;
#pragma unroll
        for (int jj = 0; jj < 2; ++jj) { const size_t off = (size_t)row * DM + col + 16 * jj; if (Rin32) p.f[jj] = *(const f32x4*)(Rin32 + off); else p.h[jj] = *(const u32x2*)(Rin16 + off); }
        return p; }
    __device__ __forceinline__ float mini(const f32x4 (&v)[2], int row, int col, int fq, const Pre& pre) const {
        float sq = 0.f;
#pragma unroll
        for (int jj = 0; jj < 2; ++jj) {
            const size_t off = (size_t)row * DM + col + 16 * jj; f32x4 r;
            if (Rin32) r = pre.f[jj];
            else { const u32x2 t = pre.h[jj]; r = (f32x4){__builtin_bit_cast(float, t.x << 16), __builtin_bit_cast(float, t.x & 0xffff0000u), __builtin_bit_cast(float, t.y << 16), __builtin_bit_cast(float, t.y & 0xffff0000u)}; }
            const f32x4 o = r + v[jj] * alpha;
            sq += (o[0] * o[0] + o[1] * o[1]) + (o[2] * o[2] + o[3] * o[3]);
            u32x2 w; w.x = pk2(o[0], o[1]); w.y = pk2(o[2], o[3]); *(u32x2*)(Rb + off) = w;
        }
        sq += __shfl_xor(sq, 16); sq += __shfl_xor(sq, 32);
        return sq;
    }
    __device__ __forceinline__ void put_ss(int row, int slot, float v) const { ssout[(size_t)row * 16 + slot] = v; }
};
struct EpiResid2 { static constexpr bool PERM = true, AFTER_DRAIN = false; EpiResid p, s;
    __device__ __forceinline__ void operator()(const f32x4 (&acc)[2][2][4][2], const Unit& u, int wr, int wc, int fr, int fq, int ui) const { if (u.pm < 64) p(acc, u, wr, wc, fr, fq, ui); else s(acc, u, wr, wc, fr, fq, ui); } };
struct EpiInproj {
    static constexpr bool PERM = true, AFTER_DRAIN = false;
    const float* ss; float* U; bf16_t *Qb, *Kb, *Vb; float* out; const LAS float* rl;
    __device__ __forceinline__ void operator()(const f32x4 (&acc)[2][2][4][2], const Unit& u, int wr, int wc, int fr, int fq, int ui) const {
        const int kind = u.pn >> 1, cbase = (u.pn & 1) * 256;
#pragma unroll
        for (int ai = 0; ai < 2; ++ai)
#pragma unroll
            for (int m = 0; m < 4; ++m) {
                const int row = u.pm * 256 + ai * 128 + wr * 64 + m * 16 + fr; const float rs = rl[256 * ui + ai * 128 + wr * 64 + m * 16 + fr];
#pragma unroll
                for (int bj = 0; bj < 2; ++bj)
#pragma unroll
                    for (int n = 0; n < 2; ++n) {
                        const int col = cbase + bj * 128 + wc * 32 + fq * 8 + n * 4; const f32x4 v = acc[ai][bj][m][n] * rs;
                        const size_t off = (size_t)row * 512 + col;
                        if (kind == 0) { *(f32x4*)(U + off) = v; }
                        else if (kind == 1) { u32x2 w; w.x = pk2(v[0] * QS_DIFF, v[1] * QS_DIFF); w.y = pk2(v[2] * QS_DIFF, v[3] * QS_DIFF); *(u32x2*)(Qb + off) = w; }
                        else {
                            float* o = out + (kind == 2 ? (row < MP ? O_KP : O_KS) : (row < MP ? O_VP : O_VS)) + (size_t)(row < MP ? row : row - MP) * 512 + col;
                            *(f32x4*)o = v; u32x2 w; w.x = pk2(v[0], v[1]); w.y = pk2(v[2], v[3]); *(u32x2*)((kind == 2 ? Kb : Vb) + off) = w;
                        }
                    }
            }
    }
    __device__ __forceinline__ void put_ss(int, int, float) const {}
    struct Pre { f32x4 q[4]; };
    __device__ __forceinline__ Pre mini_pre(int row, int) const { Pre p; const f32x4* q = (const f32x4*)(ss + (size_t)row * 16); p.q[0] = q[0]; p.q[1] = q[1]; p.q[2] = q[2]; p.q[3] = q[3]; return p; }
    __device__ __forceinline__ float mini(const f32x4 (&vv)[2], int row, int gcol, int fq, const Pre& pre) const {
        const f32x4 tq = (pre.q[0] + pre.q[1]) + (pre.q[2] + pre.q[3]); const float rs = rstd_of((tq[0] + tq[1]) + (tq[2] + tq[3])); const int kind = gcol >> 9;
#pragma unroll
        for (int jj = 0; jj < 2; ++jj) {
            const int col = (gcol & 511) + 16 * jj; const f32x4 v = vv[jj] * rs; const size_t off = (size_t)row * 512 + col;
            if (kind == 0) { *(f32x4*)(U + off) = v; }
            else if (kind == 1) { u32x2 w; w.x = pk2(v[0] * QS_DIFF, v[1] * QS_DIFF); w.y = pk2(v[2] * QS_DIFF, v[3] * QS_DIFF); *(u32x2*)(Qb + off) = w; }
            else {
                float* o = out + (kind == 2 ? (row < MP ? O_KP : O_KS) : (row < MP ? O_VP : O_VS)) + (size_t)(row < MP ? row : row - MP) * 512 + col;
                *(f32x4*)o = v; u32x2 w; w.x = pk2(v[0], v[1]); w.y = pk2(v[2], v[3]); *(u32x2*)((kind == 2 ? Kb : Vb) + off) = w;
            }
        }
        return 0.f;
    }
};
struct EpiGlu {
    static constexpr bool PERM = true, AFTER_DRAIN = false;
    const bf16_t* Y; const float* bias; bf16_t* CAT;
    __device__ __forceinline__ void operator()(const f32x4 (&acc)[2][2][4][2], const Unit& u, int wr, int wc, int fr, int fq, int ui) const {
#pragma unroll
        for (int ai = 0; ai < 2; ++ai)
#pragma unroll
            for (int m = 0; m < 4; ++m) {
                const int row = u.pm * 256 + ai * 128 + wr * 64 + m * 16 + fr;
#pragma unroll
                for (int bj = 0; bj < 2; ++bj)
#pragma unroll
                    for (int n = 0; n < 2; ++n) {
                        const int col = u.pn * 256 + bj * 128 + wc * 32 + fq * 8 + n * 4;
                        const u32x2 yv = *(const u32x2*)(Y + (size_t)row * 512 + col); const f32x4 bv = *(const f32x4*)(bias + col);
                        const float y0 = __builtin_bit_cast(float, yv.x << 16), y1 = __builtin_bit_cast(float, yv.x & 0xffff0000u), y2 = __builtin_bit_cast(float, yv.y << 16), y3 = __builtin_bit_cast(float, yv.y & 0xffff0000u);
                        const f32x4 z = acc[ai][bj][m][n] + bv;
                        const float o0 = y0 * frcp(1.f + fexp2(-z[0] * LOG2E)), o1 = y1 * frcp(1.f + fexp2(-z[1] * LOG2E)), o2 = y2 * frcp(1.f + fexp2(-z[2] * LOG2E)), o3 = y3 * frcp(1.f + fexp2(-z[3] * LOG2E));
                        u32x2 w; w.x = pk2(o0, o1); w.y = pk2(o2, o3); *(u32x2*)(CAT + (size_t)row * DM + col) = w;
                    }
            }
    }
};
struct EpiScaleBf16 {
    static constexpr bool PERM = true, AFTER_DRAIN = false;
    const float* ss; bf16_t* O; float sc;
    __device__ __forceinline__ void operator()(const f32x4 (&acc)[2][2][4][2], const Unit& u, int wr, int wc, int fr, int fq, int ui) const {
#pragma unroll
        for (int ai = 0; ai < 2; ++ai)
#pragma unroll
            for (int m = 0; m < 4; ++m) {
                const int row = u.pm * 256 + ai * 128 + wr * 64 + m * 16 + fr; const float rs = rstd_row(ss, row) * sc;
#pragma unroll
                for (int bj = 0; bj < 2; ++bj)
#pragma unroll
                    for (int n = 0; n < 2; ++n) {
                        const f32x4 v = acc[ai][bj][m][n] * rs; u32x2 w; w.x = pk2(v[0], v[1]); w.y = pk2(v[2], v[3]);
                        *(u32x2*)(O + (size_t)row * DM + u.pn * 256 + bj * 128 + wc * 32 + fq * 8 + n * 4) = w;
                    }
            }
    }
    __device__ __forceinline__ void put_ss(int, int, float) const {}
    struct Pre { f32x4 q[4]; };
    __device__ __forceinline__ Pre mini_pre(int row, int) const { Pre p; const f32x4* q = (const f32x4*)(ss + (size_t)row * 16); p.q[0] = q[0]; p.q[1] = q[1]; p.q[2] = q[2]; p.q[3] = q[3]; return p; }
    __device__ __forceinline__ float mini(const f32x4 (&vv)[2], int row, int col, int fq, const Pre& pre) const {
        const f32x4 tq = (pre.q[0] + pre.q[1]) + (pre.q[2] + pre.q[3]); const float rs = rstd_of((tq[0] + tq[1]) + (tq[2] + tq[3])) * sc;
#pragma unroll
        for (int jj = 0; jj < 2; ++jj) { const f32x4 v = vv[jj] * rs; u32x2 w; w.x = pk2(v[0], v[1]); w.y = pk2(v[2], v[3]); *(u32x2*)(O + (size_t)row * DM + col + 16 * jj) = w; }
        return 0.f;
    }
};
struct EpiMem {
    static constexpr bool PERM = true, AFTER_DRAIN = false;
    const float* ss; float* out; bf16_t *MK, *MV;
    __device__ __forceinline__ void operator()(const f32x4 (&acc)[2][2][4][2], const Unit& u, int wr, int wc, int fr, int fq, int ui) const {
        const int kind = u.pn >> 2, cbase = (u.pn & 3) * 256;
#pragma unroll
        for (int ai = 0; ai < 2; ++ai)
#pragma unroll
            for (int m = 0; m < 4; ++m) {
                const int row = u.pm * 256 + ai * 128 + wr * 64 + m * 16 + fr; const float rs = rstd_row(ss, row);
#pragma unroll
                for (int bj = 0; bj < 2; ++bj)
#pragma unroll
                    for (int n = 0; n < 2; ++n) {
                        const size_t off = (size_t)row * DM + cbase + bj * 128 + wc * 32 + fq * 8 + n * 4; const f32x4 v = acc[ai][bj][m][n] * rs;
                        *(f32x4*)(out + (kind ? O_MVP : O_MKP) + off) = v; u32x2 w; w.x = pk2(v[0], v[1]); w.y = pk2(v[2], v[3]); *(u32x2*)((kind ? MV : MK) + off) = w;
                    }
            }
    }
};

template <class Epi>
__device__ __forceinline__ void mini_gemm(LAS unsigned char* lds, const bf16_t* A, const bf16_t* Bt, int K, int r0, int c0, const Epi& E) {
    const int tid = threadIdx.x, lane = tid & 63, fr = lane & 15, g4 = lane >> 4, w = __builtin_amdgcn_readfirstlane(tid >> 6);
    const int ksteps = K / 256, kbeg = w * ksteps * 32;
    f32x4 acc[4][4];
#pragma unroll
    for (int i = 0; i < 4; ++i)
#pragma unroll
        for (int j = 0; j < 4; ++j) acc[i][j] = (f32x4){0.f, 0.f, 0.f, 0.f};
    const typename Epi::Pre pre = E.mini_pre(r0 + 16 * (w >> 1) + fr, c0 + 32 * (w & 1) + 4 * g4);
    const bf16_t* ap = A + (size_t)(r0 + fr) * K + kbeg + 8 * g4;
    const bf16_t* bp = Bt + (size_t)(c0 + fr) * K + kbeg + 8 * g4;
#pragma unroll 4
    for (int s_ = 0; s_ < ksteps; ++s_) {
        bf16x8 af[4], bf[4];
#pragma unroll
        for (int i = 0; i < 4; ++i) af[i] = *(const bf16x8*)(ap + (size_t)(16 * i) * K + 32 * s_);
#pragma unroll
        for (int j = 0; j < 4; ++j) bf[j] = *(const bf16x8*)(bp + (size_t)(16 * j) * K + 32 * s_);
#pragma unroll
        for (int i = 0; i < 4; ++i)
#pragma unroll
            for (int j = 0; j < 4; ++j) acc[i][j] = __builtin_amdgcn_mfma_f32_16x16x32_bf16(bf[j], af[i], acc[i][j], 0, 0, 0);
    }
    LAS f32x4* P = (LAS f32x4*)lds;
#pragma unroll
    for (int i = 0; i < 4; ++i)
#pragma unroll
        for (int j = 0; j < 4; ++j) P[(w * 16 + i * 4 + j) * 64 + lane] = acc[i][j];
    __syncthreads();
    const int i = w >> 1, jb = (w & 1) * 2;
    f32x4 sum[2];
#pragma unroll
    for (int jj = 0; jj < 2; ++jj) { sum[jj] = (f32x4){0.f, 0.f, 0.f, 0.f};
#pragma unroll
        for (int ww = 0; ww < 8; ++ww) sum[jj] += P[(ww * 16 + i * 4 + jb + jj) * 64 + lane]; }
    const float sq = E.mini(sum, r0 + 16 * i + fr, c0 + 16 * jb + 4 * g4, g4, pre);
    LAS float* SQ = (LAS float*)(lds + 131072);
    if (g4 == 0) SQ[w * 16 + fr] = sq;
    __syncthreads();
    if (tid < 64) E.put_ss(r0 + tid, c0 >> 6, SQ[(2 * (tid >> 4)) * 16 + (tid & 15)] + SQ[(2 * (tid >> 4) + 1) * 16 + (tid & 15)]);
    __syncthreads();
}

__device__ __forceinline__ int gu_row(int nn) { return nn < DFF ? ((nn >> 7) * 256 + (nn & 127)) : (((nn - DFF) >> 7) * 256 + 128 + ((nn - DFF) & 127)); }
__device__ __forceinline__ void tr_item(const float* W, int K, int N, bf16_t* WT, const float* g, int gumode, int rowoff, LAS float* scr, int item, int lane) {
    const int nblk = N / 32, kb = item / nblk, nb = item % nblk, k0 = 64 * kb, n0 = 32 * nb;
    float tv[32];
#pragma unroll
    for (int i = 0; i < 32; ++i) { const int kk = 2 * i + (lane >> 5); tv[i] = W[(size_t)(k0 + kk) * N + n0 + (lane & 31)]; }
#pragma unroll
    for (int i = 0; i < 32; ++i) { const int kk = 2 * i + (lane >> 5); float v = tv[i]; if (g) v *= g[k0 + kk]; scr[kk * 33 + (lane & 31)] = v; }
    asm volatile("s_waitcnt lgkmcnt(0)" ::: "memory");
    const int c = lane & 7;
#pragma unroll
    for (int j = 0; j < 4; ++j) { const int n = (lane >> 3) + 8 * j; const LAS float* s = scr + (8 * c) * 33 + n;
        u32x4 o; o.x = pk2(s[0 * 33], s[1 * 33]); o.y = pk2(s[2 * 33], s[3 * 33]); o.z = pk2(s[4 * 33], s[5 * 33]); o.w = pk2(s[6 * 33], s[7 * 33]);
        const int nn = n0 + n; const int dr = gumode ? gu_row(nn) : rowoff + nn;
        *(u32x4*)(WT + (size_t)dr * K + k0 + 8 * c) = o; }
    asm volatile("s_waitcnt lgkmcnt(0)" ::: "memory");
}
__device__ __forceinline__ void row_to_bf16(const float* src, bf16_t* dst, float* ssout, int lane) {
    const f32x4* xr = (const f32x4*)src + lane; f32x4 v[4]; float s = 0.f;
#pragma unroll
    for (int j = 0; j < 4; ++j) { v[j] = xr[64 * j]; s += (v[j][0] * v[j][0] + v[j][1] * v[j][1]) + (v[j][2] * v[j][2] + v[j][3] * v[j][3]); }
    u32x2* o = (u32x2*)dst + lane;
#pragma unroll
    for (int j = 0; j < 4; ++j) { u32x2 w; w.x = pk2(v[j][0], v[j][1]); w.y = pk2(v[j][2], v[j][3]); o[64 * j] = w; }
    if (ssout) { s = wave_sum(s); if (lane < 16) ssout[lane] = lane == 0 ? s : 0.f; }
}

__device__ __forceinline__ s16x4 tr_read(const LAS unsigned char* p) { return __builtin_amdgcn_ds_read_tr16_b64_v4i16((LAS s16x4*)p); }

template <int KROW, int VROW, int KSTR, int VSTR> struct LoaderBf16 {
    const bf16_t* kbase; const bf16_t* vbase; size_t pitch;
    static constexpr int KCH = KROW / 8, VCH = VROW / 8, NK = 64 * KCH / 512, NV = 64 * VCH / 512;
    u32x4 kr[NK], vr[NV];
    __device__ __forceinline__ void issue(int t, int tid) {
#pragma unroll
        for (int i = 0; i < NK; ++i) { const int c = tid + 512 * i, row = c / KCH, ch = c % KCH; kr[i] = *(const u32x4*)(kbase + (size_t)(64 * t + row) * pitch + ch * 8); }
#pragma unroll
        for (int i = 0; i < NV; ++i) { const int c = tid + 512 * i, row = c / VCH, ch = c % VCH; vr[i] = *(const u32x4*)(vbase + (size_t)(64 * t + row) * pitch + ch * 8); }
    }
    __device__ __forceinline__ void commit(LAS unsigned char* kl, LAS unsigned char* vl, int tid) {
#pragma unroll
        for (int i = 0; i < NK; ++i) { const int c = tid + 512 * i, row = c / KCH, ch = c % KCH; *(LAS u32x4*)(kl + row * KSTR + ch * 16) = kr[i]; }
#pragma unroll
        for (int i = 0; i < NV; ++i) { const int c = tid + 512 * i, row = c / VCH, ch = c % VCH; *(LAS u32x4*)(vl + row * VSTR + ch * 16) = vr[i]; }
    }
};
template <int KSTR, int VSTR> struct LoaderF32 {
    const float *kc, *vc, *kn, *vn;
    f32x4 kr[4], vr[4];
    __device__ __forceinline__ void issue(int t, int tid) {
        const float* kb = t < 64 ? kc + (size_t)(64 * t) * 512 : kn; const float* vb = t < 64 ? vc + (size_t)(64 * t) * 512 : vn;
#pragma unroll
        for (int i = 0; i < 4; ++i) { const int c = tid + 512 * i, row = c >> 5, ch = c & 31; kr[i] = *(const f32x4*)(kb + (size_t)row * 512 + ch * 4); vr[i] = *(const f32x4*)(vb + (size_t)row * 512 + ch * 4); }
    }
    __device__ __forceinline__ void commit(LAS unsigned char* kl, LAS unsigned char* vl, int tid) {
#pragma unroll
        for (int i = 0; i < 4; ++i) { const int c = tid + 512 * i, row = c >> 5, ch = c & 31;
            u32x2 a; a.x = pk2(kr[i][0], kr[i][1]); a.y = pk2(kr[i][2], kr[i][3]); *(LAS u32x2*)(kl + row * KSTR + ch * 8) = a;
            u32x2 b; b.x = pk2(vr[i][0], vr[i][1]); b.y = pk2(vr[i][2], vr[i][3]); *(LAS u32x2*)(vl + row * VSTR + ch * 8) = b; }
    }
};

template <int NQ, int DQK, int DV, int KSTR, int VSTR, bool ALIBI>
__device__ __forceinline__ void flash_tile(int t, LAS unsigned char* kl, LAS unsigned char* vl, const bf16x8 (&qf)[NQ][DQK / 32], int koffB, float slope2, const float (&qposf)[NQ],
                                           f32x4 (&o)[NQ][DV / 16], float (&m)[NQ], float (&l)[NQ]) {
    const int lane = threadIdx.x & 63, fr = lane & 15, g4 = lane >> 4;
    f32x4 s[NQ][4];
#pragma unroll
    for (int kb = 0; kb < 4; ++kb) {
#pragma unroll
        for (int q = 0; q < NQ; ++q) s[q][kb] = (f32x4){0.f, 0.f, 0.f, 0.f};
#pragma unroll
        for (int ks = 0; ks < DQK / 32; ++ks) { const bf16x8 a = *(const LAS bf16x8*)(kl + (16 * kb + fr) * KSTR + koffB + ks * 64 + g4 * 16);
#pragma unroll
            for (int q = 0; q < NQ; ++q) s[q][kb] = __builtin_amdgcn_mfma_f32_16x16x32_bf16(a, qf[q][ks], s[q][kb], 0, 0, 0); } }
    bf16x8 pf[NQ][2];
#pragma unroll
    for (int q = 0; q < NQ; ++q) {
        if (ALIBI) { const float d0 = qposf[q] - (float)(64 * t + 4 * g4);
#pragma unroll
            for (int kb = 0; kb < 4; ++kb)
#pragma unroll
                for (int r = 0; r < 4; ++r) s[q][kb][r] -= slope2 * __builtin_fabsf(d0 - (float)(16 * kb + r)); }
        float mx = s[q][0][0];
#pragma unroll
        for (int kb = 0; kb < 4; ++kb)
#pragma unroll
            for (int r = 0; r < 4; ++r) mx = __builtin_fmaxf(mx, s[q][kb][r]);
        mx = __builtin_fmaxf(mx, __shfl_xor(mx, 16)); mx = __builtin_fmaxf(mx, __shfl_xor(mx, 32));
        const float mn = __builtin_fmaxf(m[q], mx), alpha = fexp2(m[q] - mn); m[q] = mn;
        float ps = 0.f;
#pragma unroll
        for (int kb = 0; kb < 4; ++kb)
#pragma unroll
            for (int r = 0; r < 4; ++r) { s[q][kb][r] = fexp2(s[q][kb][r] - mn); ps += s[q][kb][r]; }
        l[q] = l[q] * alpha + ps;
#pragma unroll
        for (int vb = 0; vb < DV / 16; ++vb) o[q][vb] = o[q][vb] * alpha;
#pragma unroll
        for (int s2 = 0; s2 < 2; ++s2) { u32x4 w; w.x = pk2(s[q][2 * s2][0], s[q][2 * s2][1]); w.y = pk2(s[q][2 * s2][2], s[q][2 * s2][3]); w.z = pk2(s[q][2 * s2 + 1][0], s[q][2 * s2 + 1][1]); w.w = pk2(s[q][2 * s2 + 1][2], s[q][2 * s2 + 1][3]);
            pf[q][s2] = __builtin_bit_cast(bf16x8, w); }
    }
    const LAS unsigned char* vbase = vl + (4 * g4 + (fr >> 2)) * VSTR + (fr & 3) * 8;
#pragma unroll
    for (int vb = 0; vb < DV / 16; ++vb)
#pragma unroll
        for (int s2 = 0; s2 < 2; ++s2) {
            const s16x4 lo = tr_read(vbase + (32 * s2) * VSTR + vb * 32), hi = tr_read(vbase + (32 * s2 + 16) * VSTR + vb * 32);
            const bf16x8 a = (bf16x8){lo[0], lo[1], lo[2], lo[3], hi[0], hi[1], hi[2], hi[3]};
#pragma unroll
            for (int q = 0; q < NQ; ++q) o[q][vb] = __builtin_amdgcn_mfma_f32_16x16x32_bf16(a, pf[q][s2], o[q][vb], 0, 0, 0);
        }
}
template <int NQ, int DQK, int DV, int KSTR, int VSTR, bool ALIBI, bool DEEP, class Loader>
__device__ __forceinline__ void flash_loop(Loader& L, int t0, int t1, int tact, LAS unsigned char* lds, const bf16x8 (&qf)[NQ][DQK / 32], int koffB, float slope2, const float (&qposf)[NQ],
                                           f32x4 (&o)[NQ][DV / 16], float (&m)[NQ], float (&l)[NQ]) {
    const int tid = threadIdx.x;
    constexpr int KB = 64 * KSTR, VB = 64 * VSTR;
    LAS unsigned char* k0 = lds; LAS unsigned char* v0 = lds + KB; LAS unsigned char* k1 = lds + KB + VB; LAS unsigned char* v1 = k1 + KB;
    if constexpr (DEEP) {
        Loader L2 = L;
        L.issue(t0, tid); if (t0 + 1 < t1) L2.issue(t0 + 1, tid);
        for (int t = t0; t < t1; t += 2) {
            L.commit(k0, v0, tid);
            __syncthreads();
            if (t + 2 < t1) L.issue(t + 2, tid);
            if (t < tact) flash_tile<NQ, DQK, DV, KSTR, VSTR, ALIBI>(t, k0, v0, qf, koffB, slope2, qposf, o, m, l);
            if (t + 1 < t1) {
                L2.commit(k1, v1, tid);
                __syncthreads();
                if (t + 3 < t1) L2.issue(t + 3, tid);
                if (t + 1 < tact) flash_tile<NQ, DQK, DV, KSTR, VSTR, ALIBI>(t + 1, k1, v1, qf, koffB, slope2, qposf, o, m, l);
            }
        }
    } else {
    L.issue(t0, tid);
    for (int t = t0; t < t1; ++t) {
        const int buf = (t - t0) & 1;
        LAS unsigned char* kl = buf ? k1 : k0; LAS unsigned char* vl = buf ? v1 : v0;
        L.commit(kl, vl, tid);
        __syncthreads();
        if (t + 1 < t1) L.issue(t + 1, tid);
        if (t < tact) flash_tile<NQ, DQK, DV, KSTR, VSTR, ALIBI>(t, kl, vl, qf, koffB, slope2, qposf, o, m, l);
    }
    }
    __syncthreads();
}

constexpr int DK_STR = 272, DV_STR = 288;
constexpr int CK_STR = 528, CV_STR = 544;

__device__ __forceinline__ void diff_prompt_unit(const Args& a, LAS unsigned char* lds, int b, int h, int cp, float lam) {
    const int tid = threadIdx.x, lane = tid & 63, fr = lane & 15, g4 = lane >> 4, w = __builtin_amdgcn_readfirstlane(tid >> 6), map = w & 1, qq = w >> 1;
    const bf16_t* Qb = (const bf16_t*)(a.ws + W_QB); const bf16_t* Kb = (const bf16_t*)(a.ws + W_KB); const bf16_t* Vb = (const bf16_t*)(a.ws + W_VB);
    bf16x8 qf[2][2]; float qposf[2];
#pragma unroll
    for (int q = 0; q < 2; ++q) { const int pos = 128 * cp + 32 * qq + 16 * q + fr; qposf[q] = (float)pos;
#pragma unroll
        for (int ks = 0; ks < 2; ++ks) qf[q][ks] = *(const bf16x8*)(Qb + (size_t)(b * SEQ + pos) * 512 + h * 128 + map * 64 + 32 * ks + 8 * g4); }
    LoaderBf16<128, 128, DK_STR, DV_STR> L; L.kbase = Kb + (size_t)(b * SEQ) * 512 + h * 128; L.vbase = Vb + (size_t)(b * SEQ) * 512 + h * 128; L.pitch = 512;
    f32x4 o[2][8]; float m[2], l[2];
#pragma unroll
    for (int q = 0; q < 2; ++q) { m[q] = -INFINITY; l[q] = 0.f;
#pragma unroll
        for (int i = 0; i < 8; ++i) o[q][i] = (f32x4){0.f, 0.f, 0.f, 0.f}; }
    const float slope2 = exp2f(-2.0f * (float)(h + 1)) * LOG2E;
    flash_loop<2, 64, 128, DK_STR, DV_STR, true, false>(L, 0, 2 * cp + 2, 2 * cp + 1 + (qq >> 1), lds, qf, map * 128, slope2, qposf, o, m, l);
    LAS float* stg = (LAS float*)lds;
#pragma unroll
    for (int q = 0; q < 2; ++q) { float lt = l[q]; lt += __shfl_xor(lt, 16); lt += __shfl_xor(lt, 32); const float inv = 1.0f / lt;
#pragma unroll
        for (int vb = 0; vb < 8; ++vb) *(LAS f32x4*)(stg + (map * 128 + 32 * qq + 16 * q + fr) * 132 + 16 * vb + 4 * g4) = o[q][vb] * inv; }
    __syncthreads();
#pragma unroll
    for (int it = 0; it < 2; ++it) {
        const int idx = tid + 512 * it, q = idx >> 3, seg = idx & 7; const float* gs = a.in[26] + 16 * seg;
        float d[16]; float ss = 0.f;
#pragma unroll
        for (int i = 0; i < 16; i += 4) { const f32x4 o1 = *(const LAS f32x4*)(stg + q * 132 + 16 * seg + i), o2 = *(const LAS f32x4*)(stg + (128 + q) * 132 + 16 * seg + i);
#pragma unroll
            for (int j = 0; j < 4; ++j) { d[i + j] = o1[j] - lam * o2[j]; ss += d[i + j] * d[i + j]; } }
        ss += __shfl_xor(ss, 1); ss += __shfl_xor(ss, 2); ss += __shfl_xor(ss, 4);
        const float rn = (1.0f - LAM_INIT) / sqrtf(ss * (1.0f / 128.0f) + EPS);
        bf16_t* CAT = (bf16_t*)(a.ws + W_CAT) + (size_t)(b * SEQ + 128 * cp + q) * DM + 512 + h * 128 + 16 * seg;
        u32x4 w0, w1;
        w0.x = pk2(d[0] * rn * gs[0], d[1] * rn * gs[1]); w0.y = pk2(d[2] * rn * gs[2], d[3] * rn * gs[3]); w0.z = pk2(d[4] * rn * gs[4], d[5] * rn * gs[5]); w0.w = pk2(d[6] * rn * gs[6], d[7] * rn * gs[7]);
        w1.x = pk2(d[8] * rn * gs[8], d[9] * rn * gs[9]); w1.y = pk2(d[10] * rn * gs[10], d[11] * rn * gs[11]); w1.z = pk2(d[12] * rn * gs[12], d[13] * rn * gs[13]); w1.w = pk2(d[14] * rn * gs[14], d[15] * rn * gs[15]);
        *(u32x4*)CAT = w0; *(u32x4*)(CAT + 8) = w1;
    }
    __syncthreads();
}
__device__ __forceinline__ void diff_sample_unit(const Args& a, LAS unsigned char* lds, int b, int h, int sp) {
    const int tid = threadIdx.x, lane = tid & 63, fr = lane & 15, g4 = lane >> 4, w = __builtin_amdgcn_readfirstlane(tid >> 6), map = w & 1, qg = w >> 1;
    const bf16_t* Qb = (const bf16_t*)(a.ws + W_QB);
    const int row = MP + b * 64 + 16 * qg + fr;
    bf16x8 qf[1][2];
#pragma unroll
    for (int ks = 0; ks < 2; ++ks) qf[0][ks] = *(const bf16x8*)(Qb + (size_t)row * 512 + h * 128 + map * 64 + 32 * ks + 8 * g4);
    LoaderF32<DK_STR, DV_STR> L;
    L.kc = a.in[2] + ((size_t)b * PAST * 4 + h) * 128; L.vc = a.in[3] + ((size_t)b * PAST * 4 + h) * 128;
    L.kn = a.out + O_KS + ((size_t)b * 64 * 4 + h) * 128; L.vn = a.out + O_VS + ((size_t)b * 64 * 4 + h) * 128;
    f32x4 o[1][8];
#pragma unroll
    for (int i = 0; i < 8; ++i) o[0][i] = (f32x4){0.f, 0.f, 0.f, 0.f};
    float m[1] = {-INFINITY}, l[1] = {0.f};
    const float slope2 = exp2f(-2.0f * (float)(h + 1)) * LOG2E;
    const int t0 = 16 * sp, t1 = sp == 3 ? 65 : 16 * sp + 16;
    const float qposf[1] = {(float)(PAST + 16 * qg + fr)};
    flash_loop<1, 64, 128, DK_STR, DV_STR, true, true>(L, t0, t1, t1, lds, qf, map * 128, slope2, qposf, o, m, l);
    float lt = l[0]; lt += __shfl_xor(lt, 16); lt += __shfl_xor(lt, 32);
    const int pidx = (((b * 4 + h) * 4 + sp) * 2 + map) * 64 + 16 * qg + fr;
    float* P = (float*)(a.ws + W_PART) + (size_t)pidx * 128; float* ML = (float*)(a.ws + W_ML) + (size_t)pidx * 2;
#pragma unroll
    for (int vb = 0; vb < 8; ++vb) *(f32x4*)(P + 16 * vb + 4 * g4) = o[0][vb];
    if (g4 == 0) { ML[0] = m[0]; ML[1] = lt; }
}
__device__ __forceinline__ void cross_unit(const Args& a, LAS unsigned char* lds, int bb, int h, int qblk) {
    const int tid = threadIdx.x, lane = tid & 63, fr = lane & 15, g4 = lane >> 4, w = __builtin_amdgcn_readfirstlane(tid >> 6);
    const bf16_t* QC = (const bf16_t*)(a.ws + W_QC); bf16_t* OC = (bf16_t*)(a.ws + W_OC);
    const bool valid = bb < 8 || w < 4;
    const int row = bb < 8 ? bb * SEQ + 128 * qblk + 16 * w + fr : MP + (bb - 8) * 64 + 16 * (w & 3) + fr;
    const bf16_t* kbase = (const bf16_t*)(a.ws + W_MK) + (size_t)(bb * 256) * DM + h * 256; const bf16_t* vbase_g = (const bf16_t*)(a.ws + W_MV) + (size_t)(bb * 256) * DM + h * 256;
    constexpr int VHALF = 128 * CV_STR;
    u32x4 kr[16];
#pragma unroll
    for (int i = 0; i < 16; ++i) { const int c = tid + 512 * i; kr[i] = *(const u32x4*)(kbase + (size_t)(c >> 5) * DM + (c & 31) * 8); }
    bf16x8 qf[8];
#pragma unroll
    for (int ks = 0; ks < 8; ++ks) qf[ks] = *(const bf16x8*)(QC + (size_t)row * DM + h * 256 + 32 * ks + 8 * g4);
#pragma unroll
    for (int i = 0; i < 16; ++i) { const int c = tid + 512 * i; *(LAS u32x4*)(lds + (c >> 5) * CK_STR + (c & 31) * 16) = kr[i]; }
    __syncthreads();
    u32x4 vr[8];
#pragma unroll
    for (int i = 0; i < 8; ++i) { const int c = tid + 512 * i; vr[i] = *(const u32x4*)(vbase_g + (size_t)(c >> 5) * DM + (c & 31) * 8); }
    f32x4 s[4][4];
#pragma unroll
    for (int kt = 0; kt < 4; ++kt) {
        const LAS unsigned char* kp = lds + (64 * kt + fr) * CK_STR + g4 * 16; asm volatile("" : "+v"(kp));
#pragma unroll
        for (int kb = 0; kb < 4; ++kb) { s[kt][kb] = (f32x4){0.f, 0.f, 0.f, 0.f};
#pragma unroll
            for (int ks = 0; ks < 8; ++ks) { const bf16x8 ka = *(const LAS bf16x8*)(kp + (16 * kb) * CK_STR + ks * 64);
                s[kt][kb] = __builtin_amdgcn_mfma_f32_16x16x32_bf16(ka, qf[ks], s[kt][kb], 0, 0, 0); } } }
    float mx = s[0][0][0];
#pragma unroll
    for (int kt = 0; kt < 4; ++kt)
#pragma unroll
        for (int kb = 0; kb < 4; ++kb)
#pragma unroll
            for (int r = 0; r < 4; ++r) mx = __builtin_fmaxf(mx, s[kt][kb][r]);
    mx = __builtin_fmaxf(mx, __shfl_xor(mx, 16)); mx = __builtin_fmaxf(mx, __shfl_xor(mx, 32));
    float lt = 0.f; bf16x8 pf[4][2];
#pragma unroll
    for (int kt = 0; kt < 4; ++kt) {
#pragma unroll
        for (int kb = 0; kb < 4; ++kb)
#pragma unroll
            for (int r = 0; r < 4; ++r) { s[kt][kb][r] = fexp2(s[kt][kb][r] - mx); lt += s[kt][kb][r]; }
#pragma unroll
        for (int s2 = 0; s2 < 2; ++s2) { u32x4 wv; wv.x = pk2(s[kt][2 * s2][0], s[kt][2 * s2][1]); wv.y = pk2(s[kt][2 * s2][2], s[kt][2 * s2][3]); wv.z = pk2(s[kt][2 * s2 + 1][0], s[kt][2 * s2 + 1][1]); wv.w = pk2(s[kt][2 * s2 + 1][2], s[kt][2 * s2 + 1][3]);
            pf[kt][s2] = __builtin_bit_cast(bf16x8, wv); }
    }
    lt += __shfl_xor(lt, 16); lt += __shfl_xor(lt, 32);
    __syncthreads();
#pragma unroll
    for (int i = 0; i < 8; ++i) { const int c = tid + 512 * i; *(LAS u32x4*)(lds + (c >> 5) * CV_STR + (c & 31) * 16) = vr[i]; }
#pragma unroll
    for (int i = 0; i < 8; ++i) { const int c = tid + 512 * i; vr[i] = *(const u32x4*)(vbase_g + (size_t)(128 + (c >> 5)) * DM + (c & 31) * 8); }
    __syncthreads();
    f32x4 o[16];
#pragma unroll
    for (int i = 0; i < 16; ++i) o[i] = (f32x4){0.f, 0.f, 0.f, 0.f};
    const LAS unsigned char* vb0 = lds + (4 * g4 + (fr >> 2)) * CV_STR + (fr & 3) * 8; asm volatile("" : "+v"(vb0));
    const LAS unsigned char* vb1 = vb0 + VHALF; asm volatile("" : "+v"(vb1));
#pragma unroll
    for (int vb = 0; vb < 16; ++vb)
#pragma unroll
        for (int s4 = 0; s4 < 4; ++s4) {
            const s16x4 lo = tr_read(vb0 + (32 * s4) * CV_STR + vb * 32), hi = tr_read(vb0 + (32 * s4 + 16) * CV_STR + vb * 32);
            const bf16x8 va = (bf16x8){lo[0], lo[1], lo[2], lo[3], hi[0], hi[1], hi[2], hi[3]};
            o[vb] = __builtin_amdgcn_mfma_f32_16x16x32_bf16(va, pf[s4 >> 1][s4 & 1], o[vb], 0, 0, 0);
        }
#pragma unroll
    for (int i = 0; i < 8; ++i) { const int c = tid + 512 * i; *(LAS u32x4*)(lds + VHALF + (c >> 5) * CV_STR + (c & 31) * 16) = vr[i]; }
    __syncthreads();
#pragma unroll
    for (int vb = 0; vb < 16; ++vb)
#pragma unroll
        for (int s4 = 0; s4 < 4; ++s4) {
            const s16x4 lo = tr_read(vb1 + (32 * s4) * CV_STR + vb * 32), hi = tr_read(vb1 + (32 * s4 + 16) * CV_STR + vb * 32);
            const bf16x8 va = (bf16x8){lo[0], lo[1], lo[2], lo[3], hi[0], hi[1], hi[2], hi[3]};
            o[vb] = __builtin_amdgcn_mfma_f32_16x16x32_bf16(va, pf[2 + (s4 >> 1)][s4 & 1], o[vb], 0, 0, 0);
        }
    const float inv = 1.0f / lt;
    if (valid) {
#pragma unroll
        for (int vb = 0; vb < 16; ++vb) { const f32x4 v = o[vb] * inv; u32x2 wv; wv.x = pk2(v[0], v[1]); wv.y = pk2(v[2], v[3]); *(u32x2*)(OC + (size_t)row * DM + h * 256 + 16 * vb + 4 * g4) = wv; }
    }
    __syncthreads();
}

constexpr int S5_BU_STR = 132, S5_HS_STR = 136;
constexpr int S5_YSTG = 16 * S5_BU_STR * 4 + 16 * S5_HS_STR * 2;
constexpr int S5_WAVE_BYTES = S5_YSTG + 4096;
struct S5Frags { bf16x8 bb[8]; bf16x8 cc[4]; f32x4 dsk; float ar, ai; };
__device__ __forceinline__ bf16x8 pack8(const float* p) { u32x4 w; w.x = pk2(p[0], p[1]); w.y = pk2(p[2], p[3]); w.z = pk2(p[4], p[5]); w.w = pk2(p[6], p[7]); return __builtin_bit_cast(bf16x8, w); }
__device__ __forceinline__ void s5_load_frags(const Args& a, int g, int lane, S5Frags& F) {
    const int fr = lane & 15, g4 = lane >> 4;
    const float* BBAR = (const float*)(a.ws + W_BBAR); const float* ABAR = (const float*)(a.ws + W_ABAR);
#pragma unroll
    for (int nb = 0; nb < 8; ++nb) {
        const int pcol = 16 * nb + fr, part = pcol & 1, p = pcol >> 1;
        if (g4 < 2) F.bb[nb] = pack8(BBAR + ((size_t)((g * 2 + part) * 64 + p)) * 16 + 8 * g4); else F.bb[nb] = (bf16x8){0, 0, 0, 0, 0, 0, 0, 0};
    }
#pragma unroll
    for (int ks = 0; ks < 4; ++ks) {
        const size_t co = ((size_t)(g * 16 + fr)) * 64 + 16 * ks + 4 * g4; float t[8];
#pragma unroll
        for (int j = 0; j < 4; ++j) { t[2 * j] = a.in[19][co + j]; t[2 * j + 1] = -a.in[20][co + j]; }
        F.cc[ks] = pack8(t);
    }
    F.dsk = *(const f32x4*)(a.in[21] + g * 16 + 4 * g4);
    F.ar = ABAR[(g * 64 + lane) * 2]; F.ai = ABAR[(g * 64 + lane) * 2 + 1];
}
template <bool WRITE> __device__ __forceinline__ void s5_run(const Args& a, const S5Frags& F, int g, int r0, int nch, float& sre, float& sim, LAS unsigned char* wl, int lane) {
    const int fr = lane & 15, g4 = lane >> 4;
    const float* U = (const float*)(a.ws + W_U); bf16_t* YACT = (bf16_t*)(a.ws + W_YACT);
    LAS float* bu = (LAS float*)wl; LAS bf16_t* hs = (LAS bf16_t*)(wl + 16 * S5_BU_STR * 4);
    f32x4 ring[2][3];
#pragma unroll
    for (int k = 0; k < 2; ++k) { ring[k][0] = (f32x4){0.f, 0.f, 0.f, 0.f}; ring[k][1] = ring[k][0]; ring[k][2] = ring[k][0];
        const float* up = U + (size_t)(r0 + 16 * k + fr) * 512 + g * 16; if (g4 < 2) { ring[k][0] = *(const f32x4*)(up + 8 * g4); ring[k][1] = *(const f32x4*)(up + 8 * g4 + 4); } if (WRITE) ring[k][2] = *(const f32x4*)(up + 4 * g4); }
    for (int ch0 = 0; ch0 < nch; ch0 += 2) {
#pragma unroll
      for (int k = 0; k < 2; ++k) {
        const int ch = ch0 + k, rr = r0 + 16 * ch;
        const f32x4 u0 = ring[k][0], u1 = ring[k][1], uv = ring[k][2];
        if (ch + 2 < nch) { const float* up = U + (size_t)(rr + 32 + fr) * 512 + g * 16; if (g4 < 2) { ring[k][0] = *(const f32x4*)(up + 8 * g4); ring[k][1] = *(const f32x4*)(up + 8 * g4 + 4); } if (WRITE) ring[k][2] = *(const f32x4*)(up + 4 * g4); }
        bf16x8 uf;
        { u32x4 w; w.x = pk2(u0[0], u0[1]); w.y = pk2(u0[2], u0[3]); w.z = pk2(u1[0], u1[1]); w.w = pk2(u1[2], u1[3]); uf = __builtin_bit_cast(bf16x8, w); }
#pragma unroll
        for (int nb = 0; nb < 8; ++nb) { const f32x4 c = __builtin_amdgcn_mfma_f32_16x16x32_bf16(F.bb[nb], uf, (f32x4){0.f, 0.f, 0.f, 0.f}, 0, 0, 0);
            *(LAS f32x4*)(bu + fr * S5_BU_STR + 16 * nb + 4 * g4) = c; }
        asm volatile("s_waitcnt lgkmcnt(0)" ::: "memory");
        f32x2 bvv[16];
#pragma unroll
        for (int t = 0; t < 16; ++t) bvv[t] = *(const LAS f32x2*)(bu + t * S5_BU_STR + 2 * lane);
#pragma unroll
        for (int t = 0; t < 16; ++t) {
            const float nre = __builtin_fmaf(F.ar, sre, __builtin_fmaf(-F.ai, sim, bvv[t][0])), nim = __builtin_fmaf(F.ar, sim, __builtin_fmaf(F.ai, sre, bvv[t][1])); sre = nre; sim = nim;
            if (WRITE) *(LAS unsigned*)((LAS unsigned char*)hs + t * (S5_HS_STR * 2) + 4 * lane) = pk2(sre, sim);
        }
        asm volatile("s_waitcnt lgkmcnt(0)" ::: "memory");
        if (WRITE) {
            f32x4 y = (f32x4){0.f, 0.f, 0.f, 0.f};
#pragma unroll
            for (int ks = 0; ks < 4; ++ks) { const bf16x8 hf = *(const LAS bf16x8*)((const LAS unsigned char*)hs + fr * (S5_HS_STR * 2) + ks * 64 + g4 * 16);
                y = __builtin_amdgcn_mfma_f32_16x16x32_bf16(F.cc[ks], hf, y, 0, 0, 0); }
            float o[4];
#pragma unroll
            for (int i = 0; i < 4; ++i) { const float v = y[i] + F.dsk[i] * uv[i]; const float z = 1.5957691216057308f * (v + 0.044715f * v * v * v); o[i] = v * frcp(1.0f + fexp2(-z * LOG2E)); }
            u32x2 w; w.x = pk2(o[0], o[1]); w.y = pk2(o[2], o[3]);
            *(LAS u32x2*)(wl + S5_YSTG + (16 * (ch & 7) + fr) * 32 + g4 * 8) = w;
            asm volatile("s_waitcnt lgkmcnt(0)" ::: "memory");
            if ((ch & 7) == 7 || ch == nch - 1) {
                const int nrow = 16 * ((ch & 7) + 1), rb = r0 + 16 * (ch & ~7);
                for (int i = 0; i < nrow; i += 16) { const u32x2 yv = *(const LAS u32x2*)(wl + S5_YSTG + (i + (lane >> 2)) * 32 + (lane & 3) * 8);
                    *(u32x2*)(YACT + (size_t)(rb + i + (lane >> 2)) * 512 + g * 16 + 4 * (lane & 3)) = yv; }
                asm volatile("s_waitcnt lgkmcnt(0)" ::: "memory");
            }
        }
      }
    }
}
__device__ __forceinline__ void s5_prompt_unit(const Args& a, LAS unsigned char* lds, int b, int g) {
    const int tid = threadIdx.x, lane = tid & 63, w = __builtin_amdgcn_readfirstlane(tid >> 6);
    S5Frags F; s5_load_frags(a, g, lane, F);
    LAS unsigned char* wl = lds + w * S5_WAVE_BYTES; LAS float* E = (LAS float*)(lds + 8 * S5_WAVE_BYTES);
    const int r0 = b * SEQ + 256 * w;
    float sre = 0.f, sim = 0.f;
    s5_run<false>(a, F, g, r0, 16, sre, sim, wl, lane);
    E[(w * 64 + lane) * 2] = sre; E[(w * 64 + lane) * 2 + 1] = sim;
    __syncthreads();
    float pr = F.ar, pi = F.ai;
#pragma unroll
    for (int i = 0; i < 8; ++i) { const float nr = pr * pr - pi * pi, ni = 2.f * pr * pi; pr = nr; pi = ni; }
    sre = 0.f; sim = 0.f;
    for (int j = 0; j < w; ++j) { const float er = E[(j * 64 + lane) * 2], ei = E[(j * 64 + lane) * 2 + 1]; const float nr = pr * sre - pi * sim + er, ni = pr * sim + pi * sre + ei; sre = nr; sim = ni; }
    s5_run<true>(a, F, g, r0, 16, sre, sim, wl, lane);
    if (w == 7) { a.out[O_REP + (size_t)(b * 32 + g) * 64 + lane] = sre; a.out[O_IMP + (size_t)(b * 32 + g) * 64 + lane] = sim; }
    __syncthreads();
}
__device__ __forceinline__ void s5_sample_unit(const Args& a, LAS unsigned char* lds, int unit) {
    const int tid = threadIdx.x, lane = tid & 63, w = __builtin_amdgcn_readfirstlane(tid >> 6);
    const int sidx = unit * 8 + w, b = sidx >> 5, g = sidx & 31;
    S5Frags F; s5_load_frags(a, g, lane, F);
    LAS unsigned char* wl = lds + w * S5_WAVE_BYTES;
    float sre = a.in[4][(size_t)(b * 32 + g) * 64 + lane], sim = a.in[5][(size_t)(b * 32 + g) * 64 + lane];
    s5_run<true>(a, F, g, MP + b * 64, 4, sre, sim, wl, lane);
    a.out[O_RES + (size_t)(b * 32 + g) * 64 + lane] = sre; a.out[O_IMS + (size_t)(b * 32 + g) * 64 + lane] = sim;
}


#define GAS __attribute__((address_space(1)))
#define XB_TMO      128
#define XB_XCNT(j)  (256  + 64 * (j))
#define XB_XSUB(j)  (1280 + 64 * (j))
#define XB_XGEN(j)  (2304 + 64 * (j))
#define XB_TOP      3328
#define XB_TOPGEN   3392
#define XCD_BAR_WORDS 3456
#define XB_SPIN_CAP (1u << 18)

__device__ __forceinline__ unsigned xb_ld(unsigned* p)              { return __hip_atomic_load(p, __ATOMIC_RELAXED, __HIP_MEMORY_SCOPE_AGENT); }
__device__ __forceinline__ unsigned xb_add(unsigned* p, unsigned v) { return __hip_atomic_fetch_add(p, v, __ATOMIC_RELAXED, __HIP_MEMORY_SCOPE_AGENT); }
__device__ __forceinline__ unsigned xb_xcc_id() { return (unsigned)__builtin_amdgcn_s_getreg((3 << 11) | 20) & 0xFu; }
#define XB_SPIN(cond, bar) do { unsigned _sp = 0; while (cond) { __builtin_amdgcn_s_sleep(1); \
    if ((++_sp & 255u) == 0u) { if (xb_ld(&(bar)[XB_TMO])) break; if (_sp > XB_SPIN_CAP) { atomicAdd(&(bar)[XB_TMO], 1u); break; } } } } while (0)

struct XcdBarrier {
    unsigned* bar; unsigned x;
    volatile LAS unsigned* st;
};

__device__ __forceinline__ XcdBarrier xcd_barrier_post(unsigned* bar, volatile LAS unsigned* st) {
    XcdBarrier b; b.bar = bar; b.x = xb_xcc_id(); b.st = st;
    if (threadIdx.x == 0) (void)xb_add(&bar[XB_XCNT(b.x)], 1u);
    return b;
}
__device__ __forceinline__ void xcd_barrier_complete(unsigned* bar, unsigned x, unsigned& nloc, unsigned& nx) {
    const unsigned G = gridDim.x * gridDim.y * gridDim.z;
    unsigned sum, cnt, mine, sp = 0u;
    for (;;) {
        sum = 0u; cnt = 0u; mine = 0u;
#pragma unroll
        for (unsigned j = 0; j < 16; ++j) { const unsigned c = xb_ld(&bar[XB_XCNT(j)]); sum += c; cnt += (c > 0u) ? 1u : 0u; mine = (j == x) ? c : mine; }
        if (sum == G) break;
        __builtin_amdgcn_s_sleep(1);
        if ((++sp & 255u) == 0u) { if (xb_ld(&bar[XB_TMO])) break; if (sp > XB_SPIN_CAP) { atomicAdd(&bar[XB_TMO], 1u); break; } }
    }
    nloc = mine > 0u ? mine : 1u; nx = cnt > 0u ? cnt : 1u;
}

__device__ __forceinline__ void xcd_barrier(const XcdBarrier& b) {
    asm volatile("s_waitcnt vmcnt(0)" ::: "memory");
    __syncthreads();
    if (threadIdx.x == 0) {
        unsigned* bar = b.bar;
        __builtin_amdgcn_s_waitcnt(0);
        unsigned nloc = b.st[0], nx = b.st[1];
        if (nloc == 0u) { xcd_barrier_complete(bar, b.x, nloc, nx); b.st[0] = nloc; b.st[1] = nx; }
        const unsigned old = xb_add(&bar[XB_XSUB(b.x)], 1u);
        const unsigned gen = old / nloc;
        if (old + 1u == (gen + 1u) * nloc) {
            __builtin_amdgcn_fence(__ATOMIC_RELEASE, "agent");
            asm volatile("s_waitcnt vmcnt(0)" ::: "memory");
            const unsigned og = xb_add(&bar[XB_TOP], 1u);
            const unsigned tg = og / nx;
            if (og + 1u == (tg + 1u) * nx) xb_add(&bar[XB_TOPGEN], 1u);
            else XB_SPIN(xb_ld(&bar[XB_TOPGEN]) == tg, bar);
            __builtin_amdgcn_fence(__ATOMIC_ACQUIRE, "agent");
            xb_add(&bar[XB_XGEN(b.x)], 1u);
            asm volatile("s_waitcnt vmcnt(0)" ::: "memory");
        } else {
            XB_SPIN(xb_ld(&bar[XB_XGEN(b.x)]) == gen, bar);
            __builtin_amdgcn_fence(__ATOMIC_ACQUIRE, "agent");
            asm volatile("s_waitcnt vmcnt(0)" ::: "memory");
        }
    }
    __syncthreads();
}

constexpr int CV_GU = 16 * 176, CV_D = 44 * 32, CV_IN = 16 * 64, CV_GLU = 8 * 16, CV_SQ = 16 * 32;
constexpr int CV_NA = CV_GU + CV_D + CV_IN + CV_GLU + 3 * CV_SQ, CV_NB = CV_GU + CV_D + 2 * CV_SQ;
__device__ __forceinline__ void conv_item(const Args& a, int it, LAS float* scr, int lane) {
    unsigned char* ws = a.ws; int r = it;
    if (r < CV_GU) { tr_item(a.in[10], 1024, 5632, (bf16_t*)(ws + W_GU1), a.in[9], 1, 0, scr, r, lane); return; } r -= CV_GU;
    if (r < CV_D) { tr_item(a.in[11], 2816, 1024, (bf16_t*)(ws + W_D1), nullptr, 0, 0, scr, r, lane); return; } r -= CV_D;
    if (r < CV_IN) { tr_item(a.in[13], 1024, 2048, (bf16_t*)(ws + W_IN), a.in[12], 0, 0, scr, r, lane); return; } r -= CV_IN;
    if (r < CV_GLU) { tr_item(a.in[22], 512, 512, (bf16_t*)(ws + W_GLU), nullptr, 0, 0, scr, r, lane); return; } r -= CV_GLU;
    if (r < CV_SQ) { tr_item(a.in[27], 1024, 1024, (bf16_t*)(ws + W_OUT), nullptr, 0, 0, scr, r, lane); return; } r -= CV_SQ;
    if (r < CV_SQ) { tr_item(a.in[31], 1024, 1024, (bf16_t*)(ws + W_CKV), a.in[28], 0, 0, scr, r, lane); return; } r -= CV_SQ;
    if (r < CV_SQ) { tr_item(a.in[32], 1024, 1024, (bf16_t*)(ws + W_CKV), a.in[28], 0, 1024, scr, r, lane); return; } r -= CV_SQ;
    if (r < CV_GU) { tr_item(a.in[35], 1024, 5632, (bf16_t*)(ws + W_GU2), a.in[34], 1, 0, scr, r, lane); return; } r -= CV_GU;
    if (r < CV_D) { tr_item(a.in[36], 2816, 1024, (bf16_t*)(ws + W_D2), nullptr, 0, 0, scr, r, lane); return; } r -= CV_D;
    if (r < CV_SQ) { tr_item(a.in[30], 1024, 1024, (bf16_t*)(ws + W_CQ), a.in[29], 0, 0, scr, r, lane); return; } r -= CV_SQ;
    tr_item(a.in[33], 1024, 1024, (bf16_t*)(ws + W_CO), nullptr, 0, 0, scr, r, lane);
}

#ifndef NPH
#define NPH 13
#endif
__global__ void __launch_bounds__(512, 2) mega_fwd(Args a) {
    extern __shared__ __attribute__((aligned(16))) unsigned char lds_raw[];
    LAS unsigned char* lds = (LAS unsigned char*)lds_raw;
    cg::grid_group grid = cg::this_grid();
    const int tid = threadIdx.x, lane = tid & 63, wave = __builtin_amdgcn_readfirstlane(tid >> 6);
    const int G = gridDim.x, c = blockIdx.x;
    const int gw = c * 8 + wave, NGW = G * 8;
    unsigned char* ws = a.ws;
    float* SS = (float*)(ws + W_SSP);
    float* ss1 = SS, *ss2 = SS + (size_t)MT * 16, *ss3 = SS + (size_t)2 * MT * 16, *ss4 = SS + (size_t)3 * MT * 16, *ss5 = SS + (size_t)4 * MT * 16, *ssm = SS + (size_t)5 * MT * 16;
    bf16_t* RB = (bf16_t*)(ws + W_RB); float* R = (float*)(ws + W_R); bf16_t* H = (bf16_t*)(ws + W_H);
#define IN(k) (a.lo <= (k) && (k) < a.hi)
#define SEAM(k) do { if (IN(k) && IN((k) + 1)) xcd_barrier(bar); } while (0)

    volatile LAS unsigned* MISC = (volatile LAS unsigned*)(lds + 147440);
    if (tid < 2) MISC[tid] = 0u;
    __syncthreads();
    XcdBarrier bar = xcd_barrier_post((unsigned*)(ws + W_BAR), MISC);
    if (a.hi < 0) grid.sync();
    if (IN(0)) {
        LAS float* scr = (LAS float*)(lds + wave * 16384);
        const int itEnd = (G == 256) ? CV_NA : CV_NA + CV_NB;
        for (int it = gw; it < itEnd; it += NGW) conv_item(a, it, scr, lane);
        constexpr int NROWS = MT + 2048 + 4096 + 4096;
        for (int r2 = gw; r2 < NROWS / 2; r2 += NGW) {
            const float* src[2]; bf16_t* dst[2]; float* sso[2];
#pragma unroll
            for (int e = 0; e < 2; ++e) { const int r = 2 * r2 + e;
                if (r < MP) { src[e] = a.in[0] + (size_t)r * DM; dst[e] = RB + (size_t)r * DM; sso[e] = ss1 + (size_t)r * 16; }
                else if (r < MT) { src[e] = a.in[1] + (size_t)(r - MP) * DM; dst[e] = RB + (size_t)r * DM; sso[e] = ss1 + (size_t)r * 16; }
                else if (r < MT + 2048) { src[e] = a.in[8] + (size_t)(r - MT) * DM; dst[e] = (bf16_t*)(ws + W_MEMB) + (size_t)(r - MT) * DM; sso[e] = ssm + (size_t)(r - MT) * 16; }
                else if (r < MT + 2048 + 4096) { src[e] = a.in[6] + (size_t)(r - MT - 2048) * DM; dst[e] = (bf16_t*)(ws + W_MK) + (size_t)(r - MT) * DM; sso[e] = nullptr; }
                else { src[e] = a.in[7] + (size_t)(r - MT - 6144) * DM; dst[e] = (bf16_t*)(ws + W_MV) + (size_t)(r - MT - 4096) * DM; sso[e] = nullptr; } }
            f32x4 v[2][4];
#pragma unroll
            for (int e = 0; e < 2; ++e)
#pragma unroll
                for (int j = 0; j < 4; ++j) v[e][j] = ((const f32x4*)src[e] + lane)[64 * j];
#pragma unroll
            for (int e = 0; e < 2; ++e) { float sq = 0.f; const bool isx = (2 * r2 + e) < MT;
#pragma unroll
                for (int j = 0; j < 4; ++j) sq += (v[e][j][0] * v[e][j][0] + v[e][j][1] * v[e][j][1]) + (v[e][j][2] * v[e][j][2] + v[e][j][3] * v[e][j][3]);
                float sc = 1.0f;
                if (sso[e]) { sq = wave_sum(sq); if (lane < 16) sso[e][lane] = lane == 0 ? sq : 0.f; if (isx) sc = rstd_of(sq); }
#pragma unroll
                for (int j = 0; j < 4; ++j) { u32x2 w; w.x = pk2(v[e][j][0] * sc, v[e][j][1] * sc); w.y = pk2(v[e][j][2] * sc, v[e][j][3] * sc); ((u32x2*)dst[e] + lane)[64 * j] = w; } }
        }
        { const int gp = c * 512 + tid;
          if (gp < 2048) { const int g = gp >> 6;
            const float dt = expf(a.in[16][g]), lr = a.in[14][gp], li = a.in[15][gp];
            const float x = lr * dt, y = li * dt, er = expf(x), cy = cosf(y), sy = sinf(y), sh = sinf(0.5f * y);
            const float ar = er * cy, ai = er * sy;
            const float nr = expm1f(x) * cy - 2.f * sh * sh, ni = ai;
            const float den = lr * lr + li * li, fre = (nr * lr + ni * li) / den, fim = (ni * lr - nr * li) / den;
            float* ABAR = (float*)(ws + W_ABAR); float* BBAR = (float*)(ws + W_BBAR);
            ABAR[gp * 2] = ar; ABAR[gp * 2 + 1] = ai;
            const int p = gp & 63;
            for (int h = 0; h < 16; ++h) { const float br = a.in[17][(size_t)gp * 16 + h], bi = a.in[18][(size_t)gp * 16 + h];
                BBAR[((size_t)((g * 2 + 0) * 64 + p)) * 16 + h] = fre * br - fim * bi; BBAR[((size_t)((g * 2 + 1) * 64 + p)) * 16 + h] = fre * bi + fim * br; }
          } }
        if (c == 0 && tid == 0) { float s0 = 0.f, s1 = 0.f; for (int i = 0; i < 64; ++i) { s0 += a.in[24][i] * a.in[25][i]; s1 += a.in[24][64 + i] * a.in[25][64 + i]; }
            *(float*)(ws + W_LAM) = expf(s0) - expf(s1) + LAM_INIT; }
    }
    SEAM(0);
    if (IN(1)) {
        pg8::Gemm g{RB, (const bf16_t*)(ws + W_GU1), MT, 5632, 1024}; pg8::StaticOrder S; S.init(MT, 5632, G, c);
        EpiSwiglu<0> E{nullptr, H};
        pg8::gemm_phase<EpiSwiglu<0>, pg8::StaticOrder, true, true>(lds, g, S, E);
    }
    SEAM(1);
    if (IN(2)) {
        pg8::Gemm g{H, (const bf16_t*)(ws + W_D1), MP, 1024, 2816}; pg8::StaticOrder S; S.init(MP, 1024, G, c);
        EpiResid2 E{EpiResid{a.in[0], nullptr, RB, ss2, 0.5f}, EpiResid{a.in[1] - (size_t)MP * DM, nullptr, RB, ss2, 0.5f}};
        pg8::gemm_phase<EpiResid2, pg8::StaticOrder, true, true>(lds, g, S, E);
        for (int u = c; u < 256; u += G) mini_gemm(lds, H, (const bf16_t*)(ws + W_D1), 2816, MP + 64 * (u >> 4), 64 * (u & 15), E.s);
    }
    SEAM(2);
    if (IN(3)) {
        { pg8::Gemm g{RB, (const bf16_t*)(ws + W_IN), MP, 2048, 1024}; pg8::StaticOrder S; S.init(MP, 2048, G, c);
          LAS float* rl = (LAS float*)(lds + 131072);
          { pg8::Unit uu; for (int i = 0; i < 16 && S.next(i, uu); ++i) if (tid < 256) rl[256 * i + tid] = rstd_row(ss2, uu.pm * 256 + tid); }
          __syncthreads();
          EpiInproj E{ss2, (float*)(ws + W_U), (bf16_t*)(ws + W_QB), (bf16_t*)(ws + W_KB), (bf16_t*)(ws + W_VB), a.out, rl};
          pg8::gemm_phase<EpiInproj, pg8::StaticOrder, true, true>(lds, g, S, E);
          for (int u = c; u < 512; u += G) mini_gemm(lds, RB, (const bf16_t*)(ws + W_IN), 1024, MP + 64 * (u >> 5), 64 * (u & 31), E); }
    }
    SEAM(3);
    if (IN(4)) {
        const bool sample_first = ((c >> 3) & 1) == 0;
        if (sample_first) for (int sid = c; sid < 256; sid += G) { const int bh = sid >> 2; diff_sample_unit(a, lds, bh >> 2, bh & 3, sid & 3); }
        for (int u = c; u < 256; u += G) s5_prompt_unit(a, lds, u >> 5, u & 31);
        for (int u = c; u < 256; u += G) if ((u & 3) == 0) s5_sample_unit(a, lds, u >> 2);
        __syncthreads();
        const float lam = *(const float*)(ws + W_LAM);
        if (G == 256) {
            const int j = c >> 3, bh = 4 * (c & 7) + (j >> 3), cp = j & 7;
            diff_prompt_unit(a, lds, bh >> 2, bh & 3, 15 - cp, lam); diff_prompt_unit(a, lds, bh >> 2, bh & 3, cp, lam);
        } else
        for (int pid = c; pid < 256; pid += G) { const int bh = pid >> 3, cp = pid & 7;
            diff_prompt_unit(a, lds, bh >> 2, bh & 3, 15 - cp, lam); diff_prompt_unit(a, lds, bh >> 2, bh & 3, cp, lam); }
        if (!sample_first) for (int sid = c; sid < 256; sid += G) { const int bh = sid >> 2; diff_sample_unit(a, lds, bh >> 2, bh & 3, sid & 3); }
    }
    SEAM(4);
    if (IN(5)) {
        const float lam = *(const float*)(ws + W_LAM);
        const float* P = (const float*)(ws + W_PART); const float* ML = (const float*)(ws + W_ML); bf16_t* CAT = (bf16_t*)(ws + W_CAT);
        for (int idx = gw; idx < 4096; idx += NGW) {
            const int bh = idx >> 6, q = idx & 63; float on[2][2];
#pragma unroll
            for (int map = 0; map < 2; ++map) {
                float mm[4], ll[4]; float M = -INFINITY;
#pragma unroll
                for (int sp = 0; sp < 4; ++sp) { const int pi = ((bh * 4 + sp) * 2 + map) * 64 + q; mm[sp] = ML[pi * 2]; ll[sp] = ML[pi * 2 + 1]; M = __builtin_fmaxf(M, mm[sp]); }
                float Lt = 0.f, o0 = 0.f, o1 = 0.f;
#pragma unroll
                for (int sp = 0; sp < 4; ++sp) { const int pi = ((bh * 4 + sp) * 2 + map) * 64 + q; const float wgt = fexp2(mm[sp] - M); Lt += wgt * ll[sp];
                    const f32x2 pv = *(const f32x2*)(P + (size_t)pi * 128 + 2 * lane); o0 += wgt * pv[0]; o1 += wgt * pv[1]; }
                on[map][0] = o0 / Lt; on[map][1] = o1 / Lt;
            }
            const float d0 = on[0][0] - lam * on[1][0], d1 = on[0][1] - lam * on[1][1];
            const float ss = wave_sum(d0 * d0 + d1 * d1); const float rn = (1.0f - LAM_INIT) / sqrtf(ss * (1.0f / 128.0f) + EPS);
            const int b = bh >> 2, h = bh & 3;
            *(unsigned*)(CAT + (size_t)(MP + b * 64 + q) * DM + 512 + h * 128 + 2 * lane) = pk2(d0 * rn * a.in[26][2 * lane], d1 * rn * a.in[26][2 * lane + 1]);
        }
        pg8::Gemm g{(const bf16_t*)(ws + W_YACT), (const bf16_t*)(ws + W_GLU), MT, 512, 512}; pg8::StaticOrder S; S.init(MT, 512, G, c);
        EpiGlu E{(const bf16_t*)(ws + W_YACT), a.in[23], CAT};
        pg8::gemm_phase<EpiGlu, pg8::StaticOrder, true, true>(lds, g, S, E);
        { pg8::Gemm g2{(const bf16_t*)(ws + W_MEMB), (const bf16_t*)(ws + W_CKV), 2048, 2048, 1024}; pg8::StaticOrder S2; S2.init(2048, 2048, G, (c + G - 136) % G);
          EpiMem E2{ssm, a.out, (bf16_t*)(ws + W_MK), (bf16_t*)(ws + W_MV)};
          pg8::gemm_phase<EpiMem, pg8::StaticOrder, true, true>(lds, g2, S2, E2); }
        if (G == 256 && (c < 136 || c >= 200)) {
            LAS float* scr = (LAS float*)(lds + wave * 16384);
            const int wv = (c < 136 ? c : c - 64) * 8 + wave;
            for (int it = CV_NA + wv; it < CV_NA + CV_NB; it += 192 * 8) conv_item(a, it, scr, lane);
        }
    }
    SEAM(5);
    if (IN(6)) {
        pg8::Gemm g{(const bf16_t*)(ws + W_CAT), (const bf16_t*)(ws + W_OUT), MP, 1024, 1024}; pg8::StaticOrder S; S.init(MP, 1024, G, c);
        EpiResid E{nullptr, RB, RB, ss3, 1.0f};
        pg8::gemm_phase<EpiResid, pg8::StaticOrder, true, true>(lds, g, S, E);
        for (int u = c; u < 256; u += G) mini_gemm(lds, (const bf16_t*)(ws + W_CAT), (const bf16_t*)(ws + W_OUT), 1024, MP + 64 * (u >> 4), 64 * (u & 15), E);
    }
    SEAM(6);
    if (IN(7)) {
        pg8::Gemm g{RB, (const bf16_t*)(ws + W_CQ), MP, 1024, 1024}; pg8::StaticOrder S; S.init(MP, 1024, G, c);
        EpiScaleBf16 E{ss3, (bf16_t*)(ws + W_QC), QS_CROSS};
        pg8::gemm_phase<EpiScaleBf16, pg8::StaticOrder, true, true>(lds, g, S, E);
        for (int u = c; u < 256; u += G) mini_gemm(lds, RB, (const bf16_t*)(ws + W_CQ), 1024, MP + 64 * (u >> 4), 64 * (u & 15), E);
    }
    SEAM(7);
    if (IN(8)) {
        if (G == 256) {
            for (int i = 0; i < 2; ++i) { const int item = (c >> 3) + 32 * i, bh = 4 * (c & 7) + (item >> 4); cross_unit(a, lds, bh >> 2, bh & 3, item & 15); }
            if (c < 64) cross_unit(a, lds, 8 + (c >> 2), c & 3, 0);
        } else
        for (int u = c; u < 576; u += G) {
            if (u < 512) cross_unit(a, lds, u >> 6, (u >> 4) & 3, u & 15);
            else { const int v = u - 512; cross_unit(a, lds, 8 + (v >> 2), v & 3, 0); }
        }
    }
    SEAM(8);
    if (IN(9)) {
        pg8::Gemm g{(const bf16_t*)(ws + W_OC), (const bf16_t*)(ws + W_CO), MP, 1024, 1024}; pg8::StaticOrder S; S.init(MP, 1024, G, c);
        EpiResid E{nullptr, RB, RB, ss4, 1.0f};
        pg8::gemm_phase<EpiResid, pg8::StaticOrder, true, true>(lds, g, S, E);
        for (int u = c; u < 256; u += G) mini_gemm(lds, (const bf16_t*)(ws + W_OC), (const bf16_t*)(ws + W_CO), 1024, MP + 64 * (u >> 4), 64 * (u & 15), E);
    }
    SEAM(9);
    if (IN(10)) {
        pg8::Gemm g{RB, (const bf16_t*)(ws + W_GU2), MT, 5632, 1024}; pg8::StaticOrder S; S.init(MT, 5632, G, c);
        LAS float* rl = (LAS float*)(lds + 131072);
        { pg8::Unit uu; for (int i = 0; i < 16 && S.next(i, uu); ++i) if (tid < 256) rl[256 * i + tid] = rstd_row(ss4, uu.pm * 256 + tid); }
        __syncthreads();
        EpiSwiglu<2> E{rl, H};
        pg8::gemm_phase<EpiSwiglu<2>, pg8::StaticOrder, true, true>(lds, g, S, E);
    }
    SEAM(10);
    if (IN(11)) {
        pg8::Gemm g{H, (const bf16_t*)(ws + W_D2), MP, 1024, 2816}; pg8::StaticOrder S; S.init(MP, 1024, G, c);
        EpiResid E{nullptr, RB, RB, ss5, 0.5f};
        pg8::gemm_phase<EpiResid, pg8::StaticOrder, true, true>(lds, g, S, E);
        for (int u = c; u < 256; u += G) mini_gemm(lds, H, (const bf16_t*)(ws + W_D2), 2816, MP + 64 * (u >> 4), 64 * (u & 15), E);
    }
    SEAM(11);
    if (IN(12)) {
#pragma unroll 2
        for (int r = gw; r < MT; r += NGW) {
            const float rs = rstd_row(ss5, r); const u32x4* xr = (const u32x4*)(RB + (size_t)r * DM) + lane; const f32x4* gr = (const f32x4*)a.in[37]; f32x4* o = (f32x4*)(a.out + O_Y + (size_t)r * DM);
#pragma unroll
            for (int j = 0; j < 2; ++j) { const u32x4 t = xr[64 * j]; const int c8 = (64 * j + lane) * 2;
                const f32x4 x0 = (f32x4){__builtin_bit_cast(float, t.x << 16), __builtin_bit_cast(float, t.x & 0xffff0000u), __builtin_bit_cast(float, t.y << 16), __builtin_bit_cast(float, t.y & 0xffff0000u)};
                const f32x4 x1 = (f32x4){__builtin_bit_cast(float, t.z << 16), __builtin_bit_cast(float, t.z & 0xffff0000u), __builtin_bit_cast(float, t.w << 16), __builtin_bit_cast(float, t.w & 0xffff0000u)};
                o[c8] = x0 * gr[c8] * rs; o[c8 + 1] = x1 * gr[c8 + 1] * rs; }
        }
    }
#undef IN
#undef SEAM
}

extern "C" void kernel_launch(void* const* d_in, const int* in_sizes, int n_in, void* d_out, int out_size, void* d_ws, size_t ws_size, hipStream_t stream) {
    static int grid = 0;
    if (grid == 0) {
        if (n_in != 38 || (size_t)out_size != O_TOTAL || ws_size < W_END) { fprintf(stderr, "kernel_launch: unexpected shapes: n_in %d out %d ws %zu\n", n_in, out_size, ws_size); grid = -1; return; }
        int dev = 0, cus = 0, per_cu = 0;
        (void)hipGetDevice(&dev); (void)hipDeviceGetAttribute(&cus, hipDeviceAttributeMultiprocessorCount, dev);
        (void)hipFuncSetAttribute((const void*)mega_fwd, hipFuncAttributeMaxDynamicSharedMemorySize, LDS_BYTES);
        (void)hipOccupancyMaxActiveBlocksPerMultiprocessor(&per_cu, (const void*)mega_fwd, 512, LDS_BYTES);
        (void)hipGetLastError();
        if (per_cu < 1) fprintf(stderr, "kernel_launch: occupancy query says %d blocks per CU\n", per_cu);
        grid = cus > 0 ? cus : 256;
    }
    if (grid < 0) return;
    (void)hipMemsetAsync((char*)d_ws + W_BAR, 0, 16384, stream);
    Args a{};
    for (int i = 0; i < 38; ++i) a.in[i] = (const float*)d_in[i];
    a.out = (float*)d_out; a.ws = (unsigned char*)d_ws; a.lo = 0; a.hi = NPH;
    void* args[] = {&a};
    hipError_t e = hipLaunchCooperativeKernel((const void*)mega_fwd, dim3(grid), dim3(512), args, LDS_BYTES, stream);
    if (e != hipSuccess) fprintf(stderr, "cooperative launch failed: %s (grid %d)\n", hipGetErrorString(e), grid);
}
```

```cpp
#include <hip/hip_runtime.h>
#include <hip/hip_cooperative_groups.h>
#include <cstdio>
#include <cstdint>
#include <cmath>
namespace cg = cooperative_groups;
namespace pg8 {
#define PG8_LAS __attribute__((address_space(3)))
typedef unsigned short bf16_t;
typedef short bf16x8 __attribute__((ext_vector_type(8)));
typedef float f32x4 __attribute__((ext_vector_type(4)));
typedef unsigned u32x4 __attribute__((ext_vector_type(4)));
constexpr int BM = 256, BK = 64, HALF = 128, HTB = HALF * BK * 2  , STAGE_BYTES = 8 * HTB, NXCD = 8, WGM = 8;

__host__ __device__ __forceinline__ int lds_byte(int r, int c) { const int st = (r >> 4) * 2 + (c >> 5), rr = r & 15, cc = c & 31, ob = rr * 64 + cc * 2; return st * 1024 + (ob ^ (((ob >> 9) & 1) << 5)); }
__host__ __device__ __forceinline__ void stage_rc(int b, int& R, int& C) { const int st = b / 1024, sb = b % 1024, swz = sb ^ (((sb >> 9) & 1) << 5); R = (st >> 1) * 16 + swz / 64; C = (st & 1) * 32 + (swz % 64) / 2; }
__host__ __device__ __forceinline__ int perm32(int rho) { const int n = rho >> 4, i = rho & 15; return 8 * (i >> 2) + 4 * n + (i & 3); }

struct Unit { int pm, pn; };
struct Gemm { const bf16_t* A; const bf16_t* Bt; int M, N, K; };

struct StaticOrder {
    int nM, nN, nwg, G, c;
    __host__ __device__ void init(int M, int N, int G_, int c_) { nM = M / BM; nN = N / BM; nwg = nM * nN; G = G_; c = c_; }
    __host__ __device__ __forceinline__ bool next(int i, Unit& u) const {
        const long L = (long)i * G + c; if (L >= nwg) return false;
        int wgid = (int)L; { const int q = nwg / NXCD, r = nwg % NXCD, xcd = wgid % NXCD, off = wgid / NXCD; wgid = (xcd < r ? xcd * (q + 1) : r * (q + 1) + (xcd - r) * q) + off; }
        const int nig = WGM * nN, gid = wgid / nig, fm = gid * WGM, gsz = (nM - fm) < WGM ? (nM - fm) : WGM;
        u.pm = fm + ((wgid % nig) % gsz); u.pn = (wgid % nig) / gsz; return true;
    }
    __device__ __forceinline__ void a_ready(const Unit&) const {}
    __device__ __forceinline__ void done(const Unit&) const {}
};

__device__ __forceinline__ unsigned cvt_pk_bf16(float lo, float hi) { unsigned r; asm volatile("v_cvt_pk_bf16_f32 %0, %1, %2" : "=v"(r) : "v"(lo), "v"(hi)); return r; }
template <class Epi, class Sched, bool ALIGN_EPI = false, bool SP2 = false>
__device__ __forceinline__ void gemm_phase(PG8_LAS unsigned char* lds, const Gemm g, const Sched& S, const Epi& E) {
    const int tid = threadIdx.x, wid = __builtin_amdgcn_readfirstlane(tid >> 6), lane = tid & 63, wr = wid >> 2, wc = wid & 3, fr = lane & 15, fq = lane >> 4;
    const int K = g.K, nt = K / BK;
    unsigned voffA[2], voffB[2];
#pragma unroll
    for (int i = 0; i < 2; ++i) { int R, C; stage_rc(tid * 16 + i * 8192, R, C); const int Rb = Epi::PERM ? ((R & ~31) + perm32(R & 31)) : R;
        voffA[i] = (unsigned)(R * K + C) * 2u; voffB[i] = (unsigned)(Rb * K + C) * 2u; }
    const size_t kstep = (size_t)(BK * 2);
    const size_t hstep = (size_t)HALF * K * 2;
    const size_t tstep = 2 * hstep;
    const unsigned ldsw = (unsigned)wid * 1024u;
    const int aoff = lds_byte(wr * 64 + fr, fq * 8), boff = lds_byte(wc * 32 + fr, fq * 8);
#define PG8_SA(b, h) (((b) * 2 + (h)) * HTB)
#define PG8_SB(b, h) ((4 + (b) * 2 + (h)) * HTB)
#define PG8_STAGE(bufoff, gbase, voff) do { _Pragma("unroll") for (int _i = 0; _i < 2; ++_i) \
        __builtin_amdgcn_global_load_lds((const unsigned*)((const char*)(gbase) + (voff)[_i]), (PG8_LAS unsigned*)(lds + (bufoff) + ldsw + _i * 8192), 16, 0, 0); } while (0)
#define PG8_LDA(dst, b, h) do { _Pragma("unroll") for (int m = 0; m < 4; ++m) _Pragma("unroll") for (int k = 0; k < 2; ++k) dst[m][k] = *(const PG8_LAS bf16x8*)(lds + PG8_SA(b, h) + aoff + m * 2048 + k * 1024); } while (0)
#define PG8_LDB(dst, b, h) do { _Pragma("unroll") for (int n = 0; n < 2; ++n) _Pragma("unroll") for (int k = 0; k < 2; ++k) dst[n][k] = *(const PG8_LAS bf16x8*)(lds + PG8_SB(b, h) + boff + n * 2048 + k * 1024); } while (0)
#define PG8_MMA(ai, bj, At, Bt) do { __builtin_amdgcn_s_setprio(1); _Pragma("unroll") for (int m = 0; m < 4; ++m) _Pragma("unroll") for (int n = 0; n < 2; ++n) _Pragma("unroll") for (int k = 0; k < 2; ++k) \
        acc[ai][bj][m][n] = __builtin_amdgcn_mfma_f32_16x16x32_bf16(Bt[n][k], At[m][k], acc[ai][bj][m][n], 0, 0, 0); __builtin_amdgcn_s_setprio(0); } while (0)
#define PG8_WAIT_V(n) asm volatile("s_waitcnt vmcnt(" #n ")" ::: "memory")
#define PG8_WAIT_L(n) asm volatile("s_waitcnt lgkmcnt(" #n ")" ::: "memory")
#define PG8_BAR __builtin_amdgcn_s_barrier()
#define PG8_SCHED __builtin_amdgcn_sched_barrier(0)
    Unit cur, nxt; int ui = 0;
    if (!S.next(0, cur)) return;
    f32x4 acc[2][2][4][2];
#pragma unroll
    for (int a = 0; a < 2; ++a)
#pragma unroll
        for (int b = 0; b < 2; ++b)
#pragma unroll
            for (int m = 0; m < 4; ++m)
#pragma unroll
                for (int n = 0; n < 2; ++n) acc[a][b][m][n] = (f32x4){0.f, 0.f, 0.f, 0.f};
    bf16x8 At[4][2], B0[2][2], B1[2][2];
    const char* cA = (const char*)g.A + (size_t)cur.pm * tstep; const char* cB = (const char*)g.Bt + (size_t)cur.pn * tstep;
    S.a_ready(cur);
    if constexpr (SP2) {
        PG8_STAGE(PG8_SB(0, 0), cB, voffB); PG8_STAGE(PG8_SB(0, 1), cB + hstep, voffB); PG8_STAGE(PG8_SA(0, 0), cA, voffA); PG8_STAGE(PG8_SA(0, 1), cA + hstep, voffA);
        if (wr == 1) PG8_BAR;
        PG8_WAIT_V(2); PG8_BAR;
        PG8_STAGE(PG8_SB(1, 0), cB + kstep, voffB); PG8_STAGE(PG8_SA(1, 0), cA + kstep, voffA); PG8_STAGE(PG8_SB(1, 1), cB + hstep + kstep, voffB);
        PG8_WAIT_V(6); PG8_BAR;
    } else {
        PG8_STAGE(PG8_SB(0, 0), cB, voffB); PG8_STAGE(PG8_SA(0, 0), cA, voffA); PG8_STAGE(PG8_SB(0, 1), cB + hstep, voffB); PG8_STAGE(PG8_SA(0, 1), cA + hstep, voffA);
        if (wr == 1) PG8_BAR;
        PG8_WAIT_V(4); PG8_BAR;
        PG8_STAGE(PG8_SB(1, 0), cB + kstep, voffB); PG8_STAGE(PG8_SA(1, 0), cA + kstep, voffA); PG8_STAGE(PG8_SB(1, 1), cB + hstep + kstep, voffB);
        PG8_WAIT_V(6); PG8_BAR;
    }
    for (;;) {
        const bool has_next = S.next(ui + 1, nxt);
        const char* nA = has_next ? (const char*)g.A + (size_t)nxt.pm * tstep : cA; const char* nB = has_next ? (const char*)g.Bt + (size_t)nxt.pn * tstep : cB;
        for (int t = 0; t < nt; t += 2) {
            const bool last = (t == nt - 2);
            const char* a1 = cA + (size_t)(t + 1) * kstep;
            const char* a2 = last ? nA : cA + (size_t)(t + 2) * kstep; const char* b2 = last ? nB : cB + (size_t)(t + 2) * kstep;
            const char* a3 = a2 + kstep; const char* b3 = b2 + kstep;
            if (last && has_next) S.a_ready(nxt);
            if constexpr (SP2) {
            PG8_LDB(B0, 0, 0); PG8_LDB(B1, 0, 1); PG8_SCHED; PG8_LDA(At, 0, 0); PG8_STAGE(PG8_SA(1, 1), a1 + hstep, voffA);
            PG8_WAIT_V(8); PG8_WAIT_L(0); PG8_BAR; PG8_MMA(0, 0, At, B0); PG8_MMA(0, 1, At, B1); PG8_BAR; PG8_SCHED;
            PG8_LDA(At, 0, 1); PG8_STAGE(PG8_SB(0, 0), b2, voffB); PG8_STAGE(PG8_SB(0, 1), b2 + hstep, voffB); PG8_STAGE(PG8_SA(0, 0), a2, voffA);
            PG8_WAIT_V(8); PG8_WAIT_L(0); PG8_BAR; PG8_MMA(1, 0, At, B0); PG8_MMA(1, 1, At, B1); PG8_BAR; PG8_SCHED;
            PG8_LDB(B0, 1, 0); PG8_LDB(B1, 1, 1); PG8_SCHED; PG8_LDA(At, 1, 0); PG8_STAGE(PG8_SA(0, 1), a2 + hstep, voffA);
            PG8_WAIT_V(8); PG8_WAIT_L(0); PG8_BAR; PG8_MMA(0, 0, At, B0); PG8_MMA(0, 1, At, B1); PG8_BAR; PG8_SCHED;
            PG8_LDA(At, 1, 1); PG8_STAGE(PG8_SB(1, 0), b3, voffB); PG8_STAGE(PG8_SB(1, 1), b3 + hstep, voffB); PG8_STAGE(PG8_SA(1, 0), a3, voffA);
            PG8_WAIT_V(8); PG8_WAIT_L(0); PG8_BAR; PG8_MMA(1, 0, At, B0); PG8_MMA(1, 1, At, B1); PG8_BAR; PG8_SCHED;
            } else {
            PG8_LDB(B0, 0, 0); PG8_SCHED; PG8_LDA(At, 0, 0); PG8_STAGE(PG8_SA(1, 1), a1 + hstep, voffA);
            PG8_WAIT_L(8); PG8_BAR; PG8_WAIT_L(0); PG8_MMA(0, 0, At, B0); PG8_BAR; PG8_SCHED;
            PG8_LDB(B1, 0, 1); PG8_STAGE(PG8_SB(0, 0), b2, voffB);
            PG8_BAR; PG8_WAIT_L(0); PG8_MMA(0, 1, At, B1); PG8_BAR;
            PG8_LDA(At, 0, 1); PG8_STAGE(PG8_SA(0, 0), a2, voffA);
            PG8_BAR; PG8_WAIT_L(0); PG8_MMA(1, 0, At, B0); PG8_BAR; PG8_SCHED;
            PG8_STAGE(PG8_SB(0, 1), b2 + hstep, voffB);
            PG8_WAIT_V(6); PG8_BAR; PG8_MMA(1, 1, At, B1); PG8_BAR;
            PG8_LDB(B0, 1, 0); PG8_SCHED; PG8_LDA(At, 1, 0); PG8_STAGE(PG8_SA(0, 1), a2 + hstep, voffA);
            PG8_WAIT_L(8); PG8_BAR; PG8_WAIT_L(0); PG8_MMA(0, 0, At, B0); PG8_BAR; PG8_SCHED;
            PG8_LDB(B1, 1, 1); PG8_STAGE(PG8_SB(1, 0), b3, voffB);
            PG8_BAR; PG8_WAIT_L(0); PG8_MMA(0, 1, At, B1); PG8_BAR;
            PG8_LDA(At, 1, 1); PG8_STAGE(PG8_SA(1, 0), a3, voffA);
            PG8_BAR; PG8_WAIT_L(0); PG8_MMA(1, 0, At, B0); PG8_BAR; PG8_SCHED;
            PG8_STAGE(PG8_SB(1, 1), b3 + hstep, voffB);
            PG8_WAIT_V(6); PG8_BAR; PG8_MMA(1, 1, At, B1); PG8_BAR;
            }
        }
        if constexpr (ALIGN_EPI) { if (wr == 0) PG8_BAR; }
        if constexpr (!Epi::AFTER_DRAIN) { E(acc, cur, wr, wc, fr, fq, ui); S.done(cur); }
        if (!has_next) break;
#pragma unroll
        for (int a = 0; a < 2; ++a)
#pragma unroll
            for (int b = 0; b < 2; ++b)
#pragma unroll
                for (int m = 0; m < 4; ++m)
#pragma unroll
                    for (int n = 0; n < 2; ++n) acc[a][b][m][n] = (f32x4){0.f, 0.f, 0.f, 0.f};
        cur = nxt; cA = nA; cB = nB; ++ui;
        if constexpr (ALIGN_EPI) { if (wr == 1) PG8_BAR; }
    }
    PG8_WAIT_V(0);
    if constexpr (!ALIGN_EPI) { if (wr == 0) PG8_BAR; }
    PG8_BAR;
    if constexpr (Epi::AFTER_DRAIN) { E.fused(acc, cur, wr, wc, fr, fq, lds, wid, lane); S.done(cur); }
#undef PG8_SA
#undef PG8_SB
#undef PG8_STAGE
#undef PG8_LDA
#undef PG8_LDB
#undef PG8_MMA
#undef PG8_WAIT_V
#undef PG8_WAIT_L
#undef PG8_BAR
#undef PG8_SCHED
}
}

#define LAS __attribute__((address_space(3)))
typedef unsigned short bf16_t;
typedef short bf16x8 __attribute__((ext_vector_type(8)));
typedef short s16x4 __attribute__((ext_vector_type(4)));
typedef float f32x4 __attribute__((ext_vector_type(4)));
typedef float f32x2 __attribute__((ext_vector_type(2)));
typedef unsigned u32x4 __attribute__((ext_vector_type(4)));
typedef unsigned u32x2 __attribute__((ext_vector_type(2)));
typedef __bf16 bf16x2_t __attribute__((ext_vector_type(2)));

constexpr int MP = 16384, MS = 1024, MT = MP + MS;
constexpr int DM = 1024, DFF = 2816, SEQ = 2048, PAST = 4096;
constexpr float EPS = 1e-6f;
constexpr float LOG2E = 1.4426950408889634f;
constexpr float QS_DIFF = 0.125f * LOG2E, QS_CROSS = 0.0625f * LOG2E;
constexpr float LAM_INIT = 0.2f;

constexpr size_t O_Y = 0, O_KP = 17825792, O_VP = 26214400, O_REP = 34603008, O_IMP = 34619392, O_MKP = 34635776, O_MVP = 36732928,
                 O_KS = 38830080, O_VS = 39354368, O_RES = 39878656, O_IMS = 39911424, O_TOTAL = 39944192;
constexpr size_t MiB = 1u << 20;
constexpr size_t W_SS = 0;
constexpr size_t W_SSM = 348160, W_ABAR = 356352, W_BBAR = 372736, W_LAM = 634880;
constexpr size_t W_GU1 = 1 * MiB, W_D1 = 12 * MiB, W_IN = 18 * MiB, W_GLU = 22 * MiB, W_OUT = 23 * MiB, W_CQ = 25 * MiB, W_CKV = 27 * MiB, W_CO = 31 * MiB,
                 W_GU2 = 33 * MiB, W_D2 = 44 * MiB;
constexpr size_t W_RB = 50 * MiB, W_R = 84 * MiB, W_H = 152 * MiB, W_QC = 152 * MiB, W_OC = 186 * MiB, W_U = 246 * MiB, W_QB = 280 * MiB, W_KB = 297 * MiB,
                 W_VB = 314 * MiB, W_YACT = 331 * MiB, W_CAT = 348 * MiB, W_MEMB = 382 * MiB, W_MK = 386 * MiB, W_MV = 398 * MiB, W_PART = 410 * MiB,
                 W_ML = 426 * MiB, W_SSP = 427 * MiB, W_END = 434 * MiB;
constexpr size_t W_BAR = 655360;
constexpr int LDS_BYTES = 147456;

struct Args { const float* in[38]; float* out; unsigned char* ws; int lo, hi; };

__device__ __forceinline__ unsigned pk2(float lo, float hi) { f32x2 v = {lo, hi}; bf16x2_t b = __builtin_convertvector(v, bf16x2_t); return __builtin_bit_cast(unsigned, b); }
__device__ __forceinline__ float bf2f(bf16_t v) { return __builtin_bit_cast(float, (unsigned)v << 16); }
__device__ __forceinline__ float wave_sum(float v) {
#pragma unroll
    for (int o = 1; o < 64; o <<= 1) v += __shfl_xor(v, o);
    return v;
}
__device__ __forceinline__ float fexp2(float x) { return __builtin_amdgcn_exp2f(x); }
__device__ __forceinline__ float frcp(float x) { return __builtin_amdgcn_rcpf(x); }
__device__ __forceinline__ float rstd_of(float ss) { return 1.0f / sqrtf(ss * (1.0f / 1024.0f) + EPS); }
__device__ __forceinline__ float rstd_row(const float* ssp, int row) { const f32x4* q = (const f32x4*)(ssp + (size_t)row * 16); const f32x4 t = (q[0] + q[1]) + (q[2] + q[3]); return rstd_of((t[0] + t[1]) + (t[2] + t[3])); }

using pg8::Unit;
template <int SCALE> struct EpiSwiglu {
    static constexpr bool PERM = true, AFTER_DRAIN = false;
    const LAS float* rl; bf16_t* H;
    __device__ __forceinline__ void operator()(const f32x4 (&acc)[2][2][4][2], const Unit& u, int wr, int wc, int fr, int fq, int ui) const {
#pragma unroll
        for (int ai = 0; ai < 2; ++ai)
#pragma unroll
            for (int m = 0; m < 4; ++m) {
                const int row = u.pm * 256 + ai * 128 + wr * 64 + m * 16 + fr; float rs = 1.0f; if constexpr (SCALE == 2) rs = rl[256 * ui + ai * 128 + wr * 64 + m * 16 + fr]; float h[8];
#pragma unroll
                for (int n = 0; n < 2; ++n) {
                    const f32x4 g = acc[ai][0][m][n] * rs, up = acc[ai][1][m][n] * rs;
#pragma unroll
                    for (int i = 0; i < 4; ++i) h[4 * n + i] = g[i] * frcp(1.0f + fexp2(-g[i] * LOG2E)) * up[i];
                }
                u32x4 w; w.x = pk2(h[0], h[1]); w.y = pk2(h[2], h[3]); w.z = pk2(h[4], h[5]); w.w = pk2(h[6], h[7]);
                *(u32x4*)(H + (size_t)row * DFF + u.pn * 128 + wc * 32 + fq * 8) = w;
            }
    }
};
struct EpiResid {
    static constexpr bool PERM = true, AFTER_DRAIN = false;
    const float* Rin32; const bf16_t* Rin16; bf16_t* Rb; float* ssout; float alpha;
    __device__ __forceinline__ void operator()(const f32x4 (&acc)[2][2][4][2], const Unit& u, int wr, int wc, int fr, int fq, int ui) const {
#pragma unroll
        for (int ai = 0; ai < 2; ++ai) {
            f32x4 pre[4][2][2];
#pragma unroll
            for (int m = 0; m < 4; ++m) { const int row = u.pm * 256 + ai * 128 + wr * 64 + m * 16 + fr;
#pragma unroll
                for (int bj = 0; bj < 2; ++bj) { const size_t off = (size_t)row * DM + u.pn * 256 + bj * 128 + wc * 32 + fq * 8;
                    if (Rin32) { pre[m][bj][0] = *(const f32x4*)(Rin32 + off); pre[m][bj][1] = *(const f32x4*)(Rin32 + off + 4); }
                    else { const u32x4 t = *(const u32x4*)(Rin16 + off);
                        pre[m][bj][0] = (f32x4){__builtin_bit_cast(float, t.x << 16), __builtin_bit_cast(float, t.x & 0xffff0000u), __builtin_bit_cast(float, t.y << 16), __builtin_bit_cast(float, t.y & 0xffff0000u)};
                        pre[m][bj][1] = (f32x4){__builtin_bit_cast(float, t.z << 16), __builtin_bit_cast(float, t.z & 0xffff0000u), __builtin_bit_cast(float, t.w << 16), __builtin_bit_cast(float, t.w & 0xffff0000u)}; } } }
#pragma unroll
            for (int m = 0; m < 4; ++m) {
                const int row = u.pm * 256 + ai * 128 + wr * 64 + m * 16 + fr; float sq = 0.f;
#pragma unroll
                for (int bj = 0; bj < 2; ++bj) {
                    const size_t off = (size_t)row * DM + u.pn * 256 + bj * 128 + wc * 32 + fq * 8;
                    const f32x4 o0 = pre[m][bj][0] + acc[ai][bj][m][0] * alpha, o1 = pre[m][bj][1] + acc[ai][bj][m][1] * alpha;
                    sq += ((o0[0] * o0[0] + o0[1] * o0[1]) + (o0[2] * o0[2] + o0[3] * o0[3])) + ((o1[0] * o1[0] + o1[1] * o1[1]) + (o1[2] * o1[2] + o1[3] * o1[3]));
                    u32x4 w; w.x = pk2(o0[0], o0[1]); w.y = pk2(o0[2], o0[3]); w.z = pk2(o1[0], o1[1]); w.w = pk2(o1[2], o1[3]); *(u32x4*)(Rb + off) = w;
                }
                sq += __shfl_xor(sq, 16); sq += __shfl_xor(sq, 32);
                if (fq == 0) ssout[(size_t)row * 16 + u.pn * 4 + wc] = sq;
            }
        }
    }
    __device__ __forceinline__ float mini(const f32x4 (&v)[2], int row, int col, int fq) const {
        float sq = 0.f;
#pragma unroll
        for (int jj = 0; jj < 2; ++jj) {
            const size_t off = (size_t)row * DM + col + 16 * jj; f32x4 r;
            if (Rin32) r = *(const f32x4*)(Rin32 + off);
            else { const u32x2 t = *(const u32x2*)(Rin16 + off); r = (f32x4){__builtin_bit_cast(float, t.x << 16), __builtin_bit_cast(float, t.x & 0xffff0000u), __builtin_bit_cast(float, t.y << 16), __builtin_bit_cast(float, t.y & 0xffff0000u)}; }
            const f32x4 o = r + v[jj] * alpha;
            sq += (o[0] * o[0] + o[1] * o[1]) + (o[2] * o[2] + o[3] * o[3]);
            u32x2 w; w.x = pk2(o[0], o[1]); w.y = pk2(o[2], o[3]); *(u32x2*)(Rb + off) = w;
        }
        sq += __shfl_xor(sq, 16); sq += __shfl_xor(sq, 32);
        return sq;
    }
    __device__ __forceinline__ void put_ss(int row, int slot, float v) const { ssout[(size_t)row * 16 + slot] = v; }
};
struct EpiResid2 { static constexpr bool PERM = true, AFTER_DRAIN = false; EpiResid p, s;
    __device__ __forceinline__ void operator()(const f32x4 (&acc)[2][2][4][2], const Unit& u, int wr, int wc, int fr, int fq, int ui) const { if (u.pm < 64) p(acc, u, wr, wc, fr, fq, ui); else s(acc, u, wr, wc, fr, fq, ui); } };
struct EpiInproj {
    static constexpr bool PERM = true, AFTER_DRAIN = false;
    const float* ss; float* U; bf16_t *Qb, *Kb, *Vb; float* out; const LAS float* rl;
    __device__ __forceinline__ void operator()(const f32x4 (&acc)[2][2][4][2], const Unit& u, int wr, int wc, int fr, int fq, int ui) const {
        const int kind = u.pn >> 1, cbase = (u.pn & 1) * 256;
#pragma unroll
        for (int ai = 0; ai < 2; ++ai)
#pragma unroll
            for (int m = 0; m < 4; ++m) {
                const int row = u.pm * 256 + ai * 128 + wr * 64 + m * 16 + fr; const float rs = rl[256 * ui + ai * 128 + wr * 64 + m * 16 + fr];
#pragma unroll
                for (int bj = 0; bj < 2; ++bj)
#pragma unroll
                    for (int n = 0; n < 2; ++n) {
                        const int col = cbase + bj * 128 + wc * 32 + fq * 8 + n * 4; const f32x4 v = acc[ai][bj][m][n] * rs;
                        const size_t off = (size_t)row * 512 + col;
                        if (kind == 0) { *(f32x4*)(U + off) = v; }
                        else if (kind == 1) { u32x2 w; w.x = pk2(v[0] * QS_DIFF, v[1] * QS_DIFF); w.y = pk2(v[2] * QS_DIFF, v[3] * QS_DIFF); *(u32x2*)(Qb + off) = w; }
                        else {
                            float* o = out + (kind == 2 ? (row < MP ? O_KP : O_KS) : (row < MP ? O_VP : O_VS)) + (size_t)(row < MP ? row : row - MP) * 512 + col;
                            *(f32x4*)o = v; u32x2 w; w.x = pk2(v[0], v[1]); w.y = pk2(v[2], v[3]); *(u32x2*)((kind == 2 ? Kb : Vb) + off) = w;
                        }
                    }
            }
    }
    __device__ __forceinline__ void put_ss(int, int, float) const {}
    __device__ __forceinline__ float mini(const f32x4 (&vv)[2], int row, int gcol, int fq) const {
        const float rs = rstd_row(ss, row); const int kind = gcol >> 9;
#pragma unroll
        for (int jj = 0; jj < 2; ++jj) {
            const int col = (gcol & 511) + 16 * jj; const f32x4 v = vv[jj] * rs; const size_t off = (size_t)row * 512 + col;
            if (kind == 0) { *(f32x4*)(U + off) = v; }
            else if (kind == 1) { u32x2 w; w.x = pk2(v[0] * QS_DIFF, v[1] * QS_DIFF); w.y = pk2(v[2] * QS_DIFF, v[3] * QS_DIFF); *(u32x2*)(Qb + off) = w; }
            else {
                float* o = out + (kind == 2 ? (row < MP ? O_KP : O_KS) : (row < MP ? O_VP : O_VS)) + (size_t)(row < MP ? row : row - MP) * 512 + col;
                *(f32x4*)o = v; u32x2 w; w.x = pk2(v[0], v[1]); w.y = pk2(v[2], v[3]); *(u32x2*)((kind == 2 ? Kb : Vb) + off) = w;
            }
        }
        return 0.f;
    }
};
struct EpiGlu {
    static constexpr bool PERM = true, AFTER_DRAIN = false;
    const bf16_t* Y; const float* bias; bf16_t* CAT;
    __device__ __forceinline__ void operator()(const f32x4 (&acc)[2][2][4][2], const Unit& u, int wr, int wc, int fr, int fq, int ui) const {
#pragma unroll
        for (int ai = 0; ai < 2; ++ai)
#pragma unroll
            for (int m = 0; m < 4; ++m) {
                const int row = u.pm * 256 + ai * 128 + wr * 64 + m * 16 + fr;
#pragma unroll
                for (int bj = 0; bj < 2; ++bj)
#pragma unroll
                    for (int n = 0; n < 2; ++n) {
                        const int col = u.pn * 256 + bj * 128 + wc * 32 + fq * 8 + n * 4;
                        const u32x2 yv = *(const u32x2*)(Y + (size_t)row * 512 + col); const f32x4 bv = *(const f32x4*)(bias + col);
                        const float y0 = __builtin_bit_cast(float, yv.x << 16), y1 = __builtin_bit_cast(float, yv.x & 0xffff0000u), y2 = __builtin_bit_cast(float, yv.y << 16), y3 = __builtin_bit_cast(float, yv.y & 0xffff0000u);
                        const f32x4 z = acc[ai][bj][m][n] + bv;
                        const float o0 = y0 * frcp(1.f + fexp2(-z[0] * LOG2E)), o1 = y1 * frcp(1.f + fexp2(-z[1] * LOG2E)), o2 = y2 * frcp(1.f + fexp2(-z[2] * LOG2E)), o3 = y3 * frcp(1.f + fexp2(-z[3] * LOG2E));
                        u32x2 w; w.x = pk2(o0, o1); w.y = pk2(o2, o3); *(u32x2*)(CAT + (size_t)row * DM + col) = w;
                    }
            }
    }
};
struct EpiScaleBf16 {
    static constexpr bool PERM = true, AFTER_DRAIN = false;
    const float* ss; bf16_t* O; float sc;
    __device__ __forceinline__ void operator()(const f32x4 (&acc)[2][2][4][2], const Unit& u, int wr, int wc, int fr, int fq, int ui) const {
#pragma unroll
        for (int ai = 0; ai < 2; ++ai)
#pragma unroll
            for (int m = 0; m < 4; ++m) {
                const int row = u.pm * 256 + ai * 128 + wr * 64 + m * 16 + fr; const float rs = rstd_row(ss, row) * sc;
#pragma unroll
                for (int bj = 0; bj < 2; ++bj)
#pragma unroll
                    for (int n = 0; n < 2; ++n) {
                        const f32x4 v = acc[ai][bj][m][n] * rs; u32x2 w; w.x = pk2(v[0], v[1]); w.y = pk2(v[2], v[3]);
                        *(u32x2*)(O + (size_t)row * DM + u.pn * 256 + bj * 128 + wc * 32 + fq * 8 + n * 4) = w;
                    }
            }
    }
    __device__ __forceinline__ void put_ss(int, int, float) const {}
    __device__ __forceinline__ float mini(const f32x4 (&vv)[2], int row, int col, int fq) const {
        const float rs = rstd_row(ss, row) * sc;
#pragma unroll
        for (int jj = 0; jj < 2; ++jj) { const f32x4 v = vv[jj] * rs; u32x2 w; w.x = pk2(v[0], v[1]); w.y = pk2(v[2], v[3]); *(u32x2*)(O + (size_t)row * DM + col + 16 * jj) = w; }
        return 0.f;
    }
};
struct EpiMem {
    static constexpr bool PERM = true, AFTER_DRAIN = false;
    const float* ss; float* out; bf16_t *MK, *MV;
    __device__ __forceinline__ void operator()(const f32x4 (&acc)[2][2][4][2], const Unit& u, int wr, int wc, int fr, int fq, int ui) const {
        const int kind = u.pn >> 2, cbase = (u.pn & 3) * 256;
#pragma unroll
        for (int ai = 0; ai < 2; ++ai)
#pragma unroll
            for (int m = 0; m < 4; ++m) {
                const int row = u.pm * 256 + ai * 128 + wr * 64 + m * 16 + fr; const float rs = rstd_row(ss, row);
#pragma unroll
                for (int bj = 0; bj < 2; ++bj)
#pragma unroll
                    for (int n = 0; n < 2; ++n) {
                        const size_t off = (size_t)row * DM + cbase + bj * 128 + wc * 32 + fq * 8 + n * 4; const f32x4 v = acc[ai][bj][m][n] * rs;
                        *(f32x4*)(out + (kind ? O_MVP : O_MKP) + off) = v; u32x2 w; w.x = pk2(v[0], v[1]); w.y = pk2(v[2], v[3]); *(u32x2*)((kind ? MV : MK) + off) = w;
                    }
            }
    }
};

template <class Epi>
__device__ __forceinline__ void mini_gemm(LAS unsigned char* lds, const bf16_t* A, const bf16_t* Bt, int K, int r0, int c0, const Epi& E) {
    const int tid = threadIdx.x, lane = tid & 63, fr = lane & 15, g4 = lane >> 4, w = __builtin_amdgcn_readfirstlane(tid >> 6);
    const int ksteps = K / 256, kbeg = w * ksteps * 32;
    f32x4 acc[4][4];
#pragma unroll
    for (int i = 0; i < 4; ++i)
#pragma unroll
        for (int j = 0; j < 4; ++j) acc[i][j] = (f32x4){0.f, 0.f, 0.f, 0.f};
    const bf16_t* ap = A + (size_t)(r0 + fr) * K + kbeg + 8 * g4;
    const bf16_t* bp = Bt + (size_t)(c0 + fr) * K + kbeg + 8 * g4;
#pragma unroll 4
    for (int s_ = 0; s_ < ksteps; ++s_) {
        bf16x8 af[4], bf[4];
#pragma unroll
        for (int i = 0; i < 4; ++i) af[i] = *(const bf16x8*)(ap + (size_t)(16 * i) * K + 32 * s_);
#pragma unroll
        for (int j = 0; j < 4; ++j) bf[j] = *(const bf16x8*)(bp + (size_t)(16 * j) * K + 32 * s_);
#pragma unroll
        for (int i = 0; i < 4; ++i)
#pragma unroll
            for (int j = 0; j < 4; ++j) acc[i][j] = __builtin_amdgcn_mfma_f32_16x16x32_bf16(bf[j], af[i], acc[i][j], 0, 0, 0);
    }
    LAS f32x4* P = (LAS f32x4*)lds;
#pragma unroll
    for (int i = 0; i < 4; ++i)
#pragma unroll
        for (int j = 0; j < 4; ++j) P[(w * 16 + i * 4 + j) * 64 + lane] = acc[i][j];
    __syncthreads();
    const int i = w >> 1, jb = (w & 1) * 2;
    f32x4 sum[2];
#pragma unroll
    for (int jj = 0; jj < 2; ++jj) { sum[jj] = (f32x4){0.f, 0.f, 0.f, 0.f};
#pragma unroll
        for (int ww = 0; ww < 8; ++ww) sum[jj] += P[(ww * 16 + i * 4 + jb + jj) * 64 + lane]; }
    const float sq = E.mini(sum, r0 + 16 * i + fr, c0 + 16 * jb + 4 * g4, g4);
    LAS float* SQ = (LAS float*)(lds + 131072);
    if (g4 == 0) SQ[w * 16 + fr] = sq;
    __syncthreads();
    if (tid < 64) E.put_ss(r0 + tid, c0 >> 6, SQ[(2 * (tid >> 4)) * 16 + (tid & 15)] + SQ[(2 * (tid >> 4) + 1) * 16 + (tid & 15)]);
    __syncthreads();
}

__device__ __forceinline__ int gu_row(int nn) { return nn < DFF ? ((nn >> 7) * 256 + (nn & 127)) : (((nn - DFF) >> 7) * 256 + 128 + ((nn - DFF) & 127)); }
__device__ __forceinline__ void tr_item(const float* W, int K, int N, bf16_t* WT, const float* g, int gumode, int rowoff, LAS float* scr, int item, int lane) {
    const int nblk = N / 32, kb = item / nblk, nb = item % nblk, k0 = 64 * kb, n0 = 32 * nb;
    float tv[32];
#pragma unroll
    for (int i = 0; i < 32; ++i) { const int kk = 2 * i + (lane >> 5); tv[i] = W[(size_t)(k0 + kk) * N + n0 + (lane & 31)]; }
#pragma unroll
    for (int i = 0; i < 32; ++i) { const int kk = 2 * i + (lane >> 5); float v = tv[i]; if (g) v *= g[k0 + kk]; scr[kk * 33 + (lane & 31)] = v; }
    asm volatile("s_waitcnt lgkmcnt(0)" ::: "memory");
    const int c = lane & 7;
#pragma unroll
    for (int j = 0; j < 4; ++j) { const int n = (lane >> 3) + 8 * j; const LAS float* s = scr + (8 * c) * 33 + n;
        u32x4 o; o.x = pk2(s[0 * 33], s[1 * 33]); o.y = pk2(s[2 * 33], s[3 * 33]); o.z = pk2(s[4 * 33], s[5 * 33]); o.w = pk2(s[6 * 33], s[7 * 33]);
        const int nn = n0 + n; const int dr = gumode ? gu_row(nn) : rowoff + nn;
        *(u32x4*)(WT + (size_t)dr * K + k0 + 8 * c) = o; }
    asm volatile("s_waitcnt lgkmcnt(0)" ::: "memory");
}
__device__ __forceinline__ void row_to_bf16(const float* src, bf16_t* dst, float* ssout, int lane) {
    const f32x4* xr = (const f32x4*)src + lane; f32x4 v[4]; float s = 0.f;
#pragma unroll
    for (int j = 0; j < 4; ++j) { v[j] = xr[64 * j]; s += (v[j][0] * v[j][0] + v[j][1] * v[j][1]) + (v[j][2] * v[j][2] + v[j][3] * v[j][3]); }
    u32x2* o = (u32x2*)dst + lane;
#pragma unroll
    for (int j = 0; j < 4; ++j) { u32x2 w; w.x = pk2(v[j][0], v[j][1]); w.y = pk2(v[j][2], v[j][3]); o[64 * j] = w; }
    if (ssout) { s = wave_sum(s); if (lane < 16) ssout[lane] = lane == 0 ? s : 0.f; }
}

__device__ __forceinline__ s16x4 tr_read(const LAS unsigned char* p) { return __builtin_amdgcn_ds_read_tr16_b64_v4i16((LAS s16x4*)p); }

template <int KROW, int VROW, int KSTR, int VSTR> struct LoaderBf16 {
    const bf16_t* kbase; const bf16_t* vbase; size_t pitch;
    static constexpr int KCH = KROW / 8, VCH = VROW / 8, NK = 64 * KCH / 512, NV = 64 * VCH / 512;
    u32x4 kr[NK], vr[NV];
    __device__ __forceinline__ void issue(int t, int tid) {
#pragma unroll
        for (int i = 0; i < NK; ++i) { const int c = tid + 512 * i, row = c / KCH, ch = c % KCH; kr[i] = *(const u32x4*)(kbase + (size_t)(64 * t + row) * pitch + ch * 8); }
#pragma unroll
        for (int i = 0; i < NV; ++i) { const int c = tid + 512 * i, row = c / VCH, ch = c % VCH; vr[i] = *(const u32x4*)(vbase + (size_t)(64 * t + row) * pitch + ch * 8); }
    }
    __device__ __forceinline__ void commit(LAS unsigned char* kl, LAS unsigned char* vl, int tid) {
#pragma unroll
        for (int i = 0; i < NK; ++i) { const int c = tid + 512 * i, row = c / KCH, ch = c % KCH; *(LAS u32x4*)(kl + row * KSTR + ch * 16) = kr[i]; }
#pragma unroll
        for (int i = 0; i < NV; ++i) { const int c = tid + 512 * i, row = c / VCH, ch = c % VCH; *(LAS u32x4*)(vl + row * VSTR + ch * 16) = vr[i]; }
    }
};
template <int KSTR, int VSTR> struct LoaderF32 {
    const float *kc, *vc, *kn, *vn;
    f32x4 kr[4], vr[4];
    __device__ __forceinline__ void issue(int t, int tid) {
        const float* kb = t < 64 ? kc + (size_t)(64 * t) * 512 : kn; const float* vb = t < 64 ? vc + (size_t)(64 * t) * 512 : vn;
#pragma unroll
        for (int i = 0; i < 4; ++i) { const int c = tid + 512 * i, row = c >> 5, ch = c & 31; kr[i] = *(const f32x4*)(kb + (size_t)row * 512 + ch * 4); vr[i] = *(const f32x4*)(vb + (size_t)row * 512 + ch * 4); }
    }
    __device__ __forceinline__ void commit(LAS unsigned char* kl, LAS unsigned char* vl, int tid) {
#pragma unroll
        for (int i = 0; i < 4; ++i) { const int c = tid + 512 * i, row = c >> 5, ch = c & 31;
            u32x2 a; a.x = pk2(kr[i][0], kr[i][1]); a.y = pk2(kr[i][2], kr[i][3]); *(LAS u32x2*)(kl + row * KSTR + ch * 8) = a;
            u32x2 b; b.x = pk2(vr[i][0], vr[i][1]); b.y = pk2(vr[i][2], vr[i][3]); *(LAS u32x2*)(vl + row * VSTR + ch * 8) = b; }
    }
};

template <int NQ, int DQK, int DV, int KSTR, int VSTR, bool ALIBI>
__device__ __forceinline__ void flash_tile(int t, LAS unsigned char* kl, LAS unsigned char* vl, const bf16x8 (&qf)[NQ][DQK / 32], int koffB, float slope2, const float (&qposf)[NQ],
                                           f32x4 (&o)[NQ][DV / 16], float (&m)[NQ], float (&l)[NQ]) {
    const int lane = threadIdx.x & 63, fr = lane & 15, g4 = lane >> 4;
    f32x4 s[NQ][4];
#pragma unroll
    for (int kb = 0; kb < 4; ++kb) {
#pragma unroll
        for (int q = 0; q < NQ; ++q) s[q][kb] = (f32x4){0.f, 0.f, 0.f, 0.f};
#pragma unroll
        for (int ks = 0; ks < DQK / 32; ++ks) { const bf16x8 a = *(const LAS bf16x8*)(kl + (16 * kb + fr) * KSTR + koffB + ks * 64 + g4 * 16);
#pragma unroll
            for (int q = 0; q < NQ; ++q) s[q][kb] = __builtin_amdgcn_mfma_f32_16x16x32_bf16(a, qf[q][ks], s[q][kb], 0, 0, 0); } }
    bf16x8 pf[NQ][2];
#pragma unroll
    for (int q = 0; q < NQ; ++q) {
        if (ALIBI) { const float d0 = qposf[q] - (float)(64 * t + 4 * g4);
#pragma unroll
            for (int kb = 0; kb < 4; ++kb)
#pragma unroll
                for (int r = 0; r < 4; ++r) s[q][kb][r] -= slope2 * __builtin_fabsf(d0 - (float)(16 * kb + r)); }
        float mx = s[q][0][0];
#pragma unroll
        for (int kb = 0; kb < 4; ++kb)
#pragma unroll
            for (int r = 0; r < 4; ++r) mx = __builtin_fmaxf(mx, s[q][kb][r]);
        mx = __builtin_fmaxf(mx, __shfl_xor(mx, 16)); mx = __builtin_fmaxf(mx, __shfl_xor(mx, 32));
        if (__any(mx > m[q])) {
            const float mn_ = __builtin_fmaxf(m[q], mx), alpha = fexp2(m[q] - mn_); m[q] = mn_; l[q] *= alpha;
#pragma unroll
            for (int vb = 0; vb < DV / 16; ++vb) o[q][vb] = o[q][vb] * alpha;
        }
        const float mn = m[q];
        float ps = 0.f;
#pragma unroll
        for (int kb = 0; kb < 4; ++kb)
#pragma unroll
            for (int r = 0; r < 4; ++r) { s[q][kb][r] = fexp2(s[q][kb][r] - mn); ps += s[q][kb][r]; }
        l[q] += ps;
#pragma unroll
        for (int s2 = 0; s2 < 2; ++s2) { u32x4 w; w.x = pk2(s[q][2 * s2][0], s[q][2 * s2][1]); w.y = pk2(s[q][2 * s2][2], s[q][2 * s2][3]); w.z = pk2(s[q][2 * s2 + 1][0], s[q][2 * s2 + 1][1]); w.w = pk2(s[q][2 * s2 + 1][2], s[q][2 * s2 + 1][3]);
            pf[q][s2] = __builtin_bit_cast(bf16x8, w); }
    }
    const LAS unsigned char* vbase = vl + (4 * g4 + (fr >> 2)) * VSTR + (fr & 3) * 8;
#pragma unroll
    for (int vb = 0; vb < DV / 16; ++vb)
#pragma unroll
        for (int s2 = 0; s2 < 2; ++s2) {
            const s16x4 lo = tr_read(vbase + (32 * s2) * VSTR + vb * 32), hi = tr_read(vbase + (32 * s2 + 16) * VSTR + vb * 32);
            const bf16x8 a = (bf16x8){lo[0], lo[1], lo[2], lo[3], hi[0], hi[1], hi[2], hi[3]};
#pragma unroll
            for (int q = 0; q < NQ; ++q) o[q][vb] = __builtin_amdgcn_mfma_f32_16x16x32_bf16(a, pf[q][s2], o[q][vb], 0, 0, 0);
        }
}
template <int NQ, int DQK, int DV, int KSTR, int VSTR, bool ALIBI, bool DEEP, class Loader>
__device__ __forceinline__ void flash_loop(Loader& L, int t0, int t1, int tact, LAS unsigned char* lds, const bf16x8 (&qf)[NQ][DQK / 32], int koffB, float slope2, const float (&qposf)[NQ],
                                           f32x4 (&o)[NQ][DV / 16], float (&m)[NQ], float (&l)[NQ]) {
    const int tid = threadIdx.x;
    constexpr int KB = 64 * KSTR, VB = 64 * VSTR;
    LAS unsigned char* k0 = lds; LAS unsigned char* v0 = lds + KB; LAS unsigned char* k1 = lds + KB + VB; LAS unsigned char* v1 = k1 + KB;
    if constexpr (DEEP) {
        Loader L2 = L;
        L.issue(t1 - 1, tid); if (t1 - 2 >= t0) L2.issue(t1 - 2, tid);
        for (int t = t1 - 1; t >= t0; t -= 2) {
            L.commit(k0, v0, tid);
            __syncthreads();
            if (t - 2 >= t0) L.issue(t - 2, tid);
            if (t < tact) flash_tile<NQ, DQK, DV, KSTR, VSTR, ALIBI>(t, k0, v0, qf, koffB, slope2, qposf, o, m, l);
            if (t - 1 >= t0) {
                L2.commit(k1, v1, tid);
                __syncthreads();
                if (t - 3 >= t0) L2.issue(t - 3, tid);
                if (t - 1 < tact) flash_tile<NQ, DQK, DV, KSTR, VSTR, ALIBI>(t - 1, k1, v1, qf, koffB, slope2, qposf, o, m, l);
            }
        }
    } else {
    L.issue(t1 - 1, tid);
    for (int t = t1 - 1; t >= t0; --t) {
        const int buf = (t1 - 1 - t) & 1;
        LAS unsigned char* kl = buf ? k1 : k0; LAS unsigned char* vl = buf ? v1 : v0;
        L.commit(kl, vl, tid);
        __syncthreads();
        if (t - 1 >= t0) L.issue(t - 1, tid);
        if (t < tact) flash_tile<NQ, DQK, DV, KSTR, VSTR, ALIBI>(t, kl, vl, qf, koffB, slope2, qposf, o, m, l);
    }
    }
    __syncthreads();
}

constexpr int DK_STR = 272, DV_STR = 288;
constexpr int CK_STR = 528, CV_STR = 544;

__device__ __forceinline__ void diff_prompt_unit(const Args& a, LAS unsigned char* lds, int b, int h, int cp, float lam) {
    const int tid = threadIdx.x, lane = tid & 63, fr = lane & 15, g4 = lane >> 4, w = __builtin_amdgcn_readfirstlane(tid >> 6), map = w & 1, qq = w >> 1;
    const bf16_t* Qb = (const bf16_t*)(a.ws + W_QB); const bf16_t* Kb = (const bf16_t*)(a.ws + W_KB); const bf16_t* Vb = (const bf16_t*)(a.ws + W_VB);
    bf16x8 qf[2][2]; float qposf[2];
#pragma unroll
    for (int q = 0; q < 2; ++q) { const int pos = 128 * cp + 32 * qq + 16 * q + fr; qposf[q] = (float)pos;
#pragma unroll
        for (int ks = 0; ks < 2; ++ks) qf[q][ks] = *(const bf16x8*)(Qb + (size_t)(b * SEQ + pos) * 512 + h * 128 + map * 64 + 32 * ks + 8 * g4); }
    LoaderBf16<128, 128, DK_STR, DV_STR> L; L.kbase = Kb + (size_t)(b * SEQ) * 512 + h * 128; L.vbase = Vb + (size_t)(b * SEQ) * 512 + h * 128; L.pitch = 512;
    f32x4 o[2][8]; float m[2], l[2];
#pragma unroll
    for (int q = 0; q < 2; ++q) { m[q] = -INFINITY; l[q] = 0.f;
#pragma unroll
        for (int i = 0; i < 8; ++i) o[q][i] = (f32x4){0.f, 0.f, 0.f, 0.f}; }
    const float slope2 = exp2f(-2.0f * (float)(h + 1)) * LOG2E;
    flash_loop<2, 64, 128, DK_STR, DV_STR, true, false>(L, 0, 2 * cp + 2, 2 * cp + 1 + (qq >> 1), lds, qf, map * 128, slope2, qposf, o, m, l);
    LAS float* stg = (LAS float*)lds;
#pragma unroll
    for (int q = 0; q < 2; ++q) { float lt = l[q]; lt += __shfl_xor(lt, 16); lt += __shfl_xor(lt, 32); const float inv = 1.0f / lt;
#pragma unroll
        for (int vb = 0; vb < 8; ++vb) *(LAS f32x4*)(stg + (map * 128 + 32 * qq + 16 * q + fr) * 132 + 16 * vb + 4 * g4) = o[q][vb] * inv; }
    __syncthreads();
#pragma unroll
    for (int it = 0; it < 2; ++it) {
        const int idx = tid + 512 * it, q = idx >> 3, seg = idx & 7; const float* gs = a.in[26] + 16 * seg;
        float d[16]; float ss = 0.f;
#pragma unroll
        for (int i = 0; i < 16; i += 4) { const f32x4 o1 = *(const LAS f32x4*)(stg + q * 132 + 16 * seg + i), o2 = *(const LAS f32x4*)(stg + (128 + q) * 132 + 16 * seg + i);
#pragma unroll
            for (int j = 0; j < 4; ++j) { d[i + j] = o1[j] - lam * o2[j]; ss += d[i + j] * d[i + j]; } }
        ss += __shfl_xor(ss, 1); ss += __shfl_xor(ss, 2); ss += __shfl_xor(ss, 4);
        const float rn = (1.0f - LAM_INIT) / sqrtf(ss * (1.0f / 128.0f) + EPS);
        bf16_t* CAT = (bf16_t*)(a.ws + W_CAT) + (size_t)(b * SEQ + 128 * cp + q) * DM + 512 + h * 128 + 16 * seg;
        u32x4 w0, w1;
        w0.x = pk2(d[0] * rn * gs[0], d[1] * rn * gs[1]); w0.y = pk2(d[2] * rn * gs[2], d[3] * rn * gs[3]); w0.z = pk2(d[4] * rn * gs[4], d[5] * rn * gs[5]); w0.w = pk2(d[6] * rn * gs[6], d[7] * rn * gs[7]);
        w1.x = pk2(d[8] * rn * gs[8], d[9] * rn * gs[9]); w1.y = pk2(d[10] * rn * gs[10], d[11] * rn * gs[11]); w1.z = pk2(d[12] * rn * gs[12], d[13] * rn * gs[13]); w1.w = pk2(d[14] * rn * gs[14], d[15] * rn * gs[15]);
        *(u32x4*)CAT = w0; *(u32x4*)(CAT + 8) = w1;
    }
    __syncthreads();
}
__device__ __forceinline__ void diff_sample_unit(const Args& a, LAS unsigned char* lds, int b, int h, int sp) {
    const int tid = threadIdx.x, lane = tid & 63, fr = lane & 15, g4 = lane >> 4, w = __builtin_amdgcn_readfirstlane(tid >> 6), map = w & 1, qg = w >> 1;
    const bf16_t* Qb = (const bf16_t*)(a.ws + W_QB);
    const int row = MP + b * 64 + 16 * qg + fr;
    bf16x8 qf[1][2];
#pragma unroll
    for (int ks = 0; ks < 2; ++ks) qf[0][ks] = *(const bf16x8*)(Qb + (size_t)row * 512 + h * 128 + map * 64 + 32 * ks + 8 * g4);
    LoaderF32<DK_STR, DV_STR> L;
    L.kc = a.in[2] + ((size_t)b * PAST * 4 + h) * 128; L.vc = a.in[3] + ((size_t)b * PAST * 4 + h) * 128;
    L.kn = a.out + O_KS + ((size_t)b * 64 * 4 + h) * 128; L.vn = a.out + O_VS + ((size_t)b * 64 * 4 + h) * 128;
    f32x4 o[1][8];
#pragma unroll
    for (int i = 0; i < 8; ++i) o[0][i] = (f32x4){0.f, 0.f, 0.f, 0.f};
    float m[1] = {-INFINITY}, l[1] = {0.f};
    const float slope2 = exp2f(-2.0f * (float)(h + 1)) * LOG2E;
    const int t0 = 16 * sp, t1 = sp == 3 ? 65 : 16 * sp + 16;
    const float qposf[1] = {(float)(PAST + 16 * qg + fr)};
    flash_loop<1, 64, 128, DK_STR, DV_STR, true, true>(L, t0, t1, t1, lds, qf, map * 128, slope2, qposf, o, m, l);
    float lt = l[0]; lt += __shfl_xor(lt, 16); lt += __shfl_xor(lt, 32);
    const int pidx = (((b * 4 + h) * 4 + sp) * 2 + map) * 64 + 16 * qg + fr;
    float* P = (float*)(a.ws + W_PART) + (size_t)pidx * 128; float* ML = (float*)(a.ws + W_ML) + (size_t)pidx * 2;
#pragma unroll
    for (int vb = 0; vb < 8; ++vb) *(f32x4*)(P + 16 * vb + 4 * g4) = o[0][vb];
    if (g4 == 0) { ML[0] = m[0]; ML[1] = lt; }
}
__device__ __forceinline__ void cross_unit(const Args& a, LAS unsigned char* lds, int bb, int h, int qblk) {
    const int tid = threadIdx.x, lane = tid & 63, fr = lane & 15, g4 = lane >> 4, w = __builtin_amdgcn_readfirstlane(tid >> 6);
    const bf16_t* QC = (const bf16_t*)(a.ws + W_QC); bf16_t* OC = (bf16_t*)(a.ws + W_OC);
    const bool valid = bb < 8 || w < 4;
    const int row = bb < 8 ? bb * SEQ + 128 * qblk + 16 * w + fr : MP + (bb - 8) * 64 + 16 * (w & 3) + fr;
    const bf16_t* kbase = (const bf16_t*)(a.ws + W_MK) + (size_t)(bb * 256) * DM + h * 256; const bf16_t* vbase_g = (const bf16_t*)(a.ws + W_MV) + (size_t)(bb * 256) * DM + h * 256;
    constexpr int VHALF = 128 * CV_STR;
    u32x4 kr[16];
#pragma unroll
    for (int i = 0; i < 16; ++i) { const int c = tid + 512 * i; kr[i] = *(const u32x4*)(kbase + (size_t)(c >> 5) * DM + (c & 31) * 8); }
    bf16x8 qf[8];
#pragma unroll
    for (int ks = 0; ks < 8; ++ks) qf[ks] = *(const bf16x8*)(QC + (size_t)row * DM + h * 256 + 32 * ks + 8 * g4);
#pragma unroll
    for (int i = 0; i < 16; ++i) { const int c = tid + 512 * i; *(LAS u32x4*)(lds + (c >> 5) * CK_STR + (c & 31) * 16) = kr[i]; }
    __syncthreads();
    u32x4 vr[8];
#pragma unroll
    for (int i = 0; i < 8; ++i) { const int c = tid + 512 * i; vr[i] = *(const u32x4*)(vbase_g + (size_t)(c >> 5) * DM + (c & 31) * 8); }
    f32x4 s[4][4];
#pragma unroll
    for (int kt = 0; kt < 4; ++kt) {
        const LAS unsigned char* kp = lds + (64 * kt + fr) * CK_STR + g4 * 16; asm volatile("" : "+v"(kp));
#pragma unroll
        for (int kb = 0; kb < 4; ++kb) { s[kt][kb] = (f32x4){0.f, 0.f, 0.f, 0.f};
#pragma unroll
            for (int ks = 0; ks < 8; ++ks) { const bf16x8 ka = *(const LAS bf16x8*)(kp + (16 * kb) * CK_STR + ks * 64);
                s[kt][kb] = __builtin_amdgcn_mfma_f32_16x16x32_bf16(ka, qf[ks], s[kt][kb], 0, 0, 0); } } }
    float mx = s[0][0][0];
#pragma unroll
    for (int kt = 0; kt < 4; ++kt)
#pragma unroll
        for (int kb = 0; kb < 4; ++kb)
#pragma unroll
            for (int r = 0; r < 4; ++r) mx = __builtin_fmaxf(mx, s[kt][kb][r]);
    mx = __builtin_fmaxf(mx, __shfl_xor(mx, 16)); mx = __builtin_fmaxf(mx, __shfl_xor(mx, 32));
    float lt = 0.f; bf16x8 pf[4][2];
#pragma unroll
    for (int kt = 0; kt < 4; ++kt) {
#pragma unroll
        for (int kb = 0; kb < 4; ++kb)
#pragma unroll
            for (int r = 0; r < 4; ++r) { s[kt][kb][r] = fexp2(s[kt][kb][r] - mx); lt += s[kt][kb][r]; }
#pragma unroll
        for (int s2 = 0; s2 < 2; ++s2) { u32x4 wv; wv.x = pk2(s[kt][2 * s2][0], s[kt][2 * s2][1]); wv.y = pk2(s[kt][2 * s2][2], s[kt][2 * s2][3]); wv.z = pk2(s[kt][2 * s2 + 1][0], s[kt][2 * s2 + 1][1]); wv.w = pk2(s[kt][2 * s2 + 1][2], s[kt][2 * s2 + 1][3]);
            pf[kt][s2] = __builtin_bit_cast(bf16x8, wv); }
    }
    lt += __shfl_xor(lt, 16); lt += __shfl_xor(lt, 32);
    __syncthreads();
#pragma unroll
    for (int i = 0; i < 8; ++i) { const int c = tid + 512 * i; *(LAS u32x4*)(lds + (c >> 5) * CV_STR + (c & 31) * 16) = vr[i]; }
#pragma unroll
    for (int i = 0; i < 8; ++i) { const int c = tid + 512 * i; vr[i] = *(const u32x4*)(vbase_g + (size_t)(128 + (c >> 5)) * DM + (c & 31) * 8); }
    __syncthreads();
    f32x4 o[16];
#pragma unroll
    for (int i = 0; i < 16; ++i) o[i] = (f32x4){0.f, 0.f, 0.f, 0.f};
    const LAS unsigned char* vb0 = lds + (4 * g4 + (fr >> 2)) * CV_STR + (fr & 3) * 8; asm volatile("" : "+v"(vb0));
    const LAS unsigned char* vb1 = vb0 + VHALF; asm volatile("" : "+v"(vb1));
#pragma unroll
    for (int vb = 0; vb < 16; ++vb)
#pragma unroll
        for (int s4 = 0; s4 < 4; ++s4) {
            const s16x4 lo = tr_read(vb0 + (32 * s4) * CV_STR + vb * 32), hi = tr_read(vb0 + (32 * s4 + 16) * CV_STR + vb * 32);
            const bf16x8 va = (bf16x8){lo[0], lo[1], lo[2], lo[3], hi[0], hi[1], hi[2], hi[3]};
            o[vb] = __builtin_amdgcn_mfma_f32_16x16x32_bf16(va, pf[s4 >> 1][s4 & 1], o[vb], 0, 0, 0);
        }
#pragma unroll
    for (int i = 0; i < 8; ++i) { const int c = tid + 512 * i; *(LAS u32x4*)(lds + VHALF + (c >> 5) * CV_STR + (c & 31) * 16) = vr[i]; }
    __syncthreads();
#pragma unroll
    for (int vb = 0; vb < 16; ++vb)
#pragma unroll
        for (int s4 = 0; s4 < 4; ++s4) {
            const s16x4 lo = tr_read(vb1 + (32 * s4) * CV_STR + vb * 32), hi = tr_read(vb1 + (32 * s4 + 16) * CV_STR + vb * 32);
            const bf16x8 va = (bf16x8){lo[0], lo[1], lo[2], lo[3], hi[0], hi[1], hi[2], hi[3]};
            o[vb] = __builtin_amdgcn_mfma_f32_16x16x32_bf16(va, pf[2 + (s4 >> 1)][s4 & 1], o[vb], 0, 0, 0);
        }
    const float inv = 1.0f / lt;
    if (valid) {
#pragma unroll
        for (int vb = 0; vb < 16; ++vb) { const f32x4 v = o[vb] * inv; u32x2 wv; wv.x = pk2(v[0], v[1]); wv.y = pk2(v[2], v[3]); *(u32x2*)(OC + (size_t)row * DM + h * 256 + 16 * vb + 4 * g4) = wv; }
    }
    __syncthreads();
}

constexpr int S5_BU_STR = 132, S5_HS_STR = 136;
constexpr int S5_YSTG = 16 * S5_BU_STR * 4 + 16 * S5_HS_STR * 2;
constexpr int S5_WAVE_BYTES = S5_YSTG + 4096;
struct S5Frags { bf16x8 bb[8]; bf16x8 cc[4]; f32x4 dsk; float ar, ai; };
__device__ __forceinline__ bf16x8 pack8(const float* p) { u32x4 w; w.x = pk2(p[0], p[1]); w.y = pk2(p[2], p[3]); w.z = pk2(p[4], p[5]); w.w = pk2(p[6], p[7]); return __builtin_bit_cast(bf16x8, w); }
__device__ __forceinline__ void s5_load_frags(const Args& a, int g, int lane, S5Frags& F) {
    const int fr = lane & 15, g4 = lane >> 4;
    const float* BBAR = (const float*)(a.ws + W_BBAR); const float* ABAR = (const float*)(a.ws + W_ABAR);
#pragma unroll
    for (int nb = 0; nb < 8; ++nb) {
        const int pcol = 16 * nb + fr, part = pcol & 1, p = pcol >> 1;
        if (g4 < 2) F.bb[nb] = pack8(BBAR + ((size_t)((g * 2 + part) * 64 + p)) * 16 + 8 * g4); else F.bb[nb] = (bf16x8){0, 0, 0, 0, 0, 0, 0, 0};
    }
#pragma unroll
    for (int ks = 0; ks < 4; ++ks) {
        const size_t co = ((size_t)(g * 16 + fr)) * 64 + 16 * ks + 4 * g4; float t[8];
#pragma unroll
        for (int j = 0; j < 4; ++j) { t[2 * j] = a.in[19][co + j]; t[2 * j + 1] = -a.in[20][co + j]; }
        F.cc[ks] = pack8(t);
    }
    F.dsk = *(const f32x4*)(a.in[21] + g * 16 + 4 * g4);
    F.ar = ABAR[(g * 64 + lane) * 2]; F.ai = ABAR[(g * 64 + lane) * 2 + 1];
}
template <bool WRITE> __device__ __forceinline__ void s5_run(const Args& a, const S5Frags& F, int g, int r0, int nch, float& sre, float& sim, LAS unsigned char* wl, int lane) {
    const int fr = lane & 15, g4 = lane >> 4;
    const float* U = (const float*)(a.ws + W_U); bf16_t* YACT = (bf16_t*)(a.ws + W_YACT);
    LAS float* bu = (LAS float*)wl; LAS bf16_t* hs = (LAS bf16_t*)(wl + 16 * S5_BU_STR * 4);
    f32x4 ring[2][3];
#pragma unroll
    for (int k = 0; k < 2; ++k) { ring[k][0] = (f32x4){0.f, 0.f, 0.f, 0.f}; ring[k][1] = ring[k][0]; ring[k][2] = ring[k][0];
        const float* up = U + (size_t)(r0 + 16 * k + fr) * 512 + g * 16; if (g4 < 2) { ring[k][0] = *(const f32x4*)(up + 8 * g4); ring[k][1] = *(const f32x4*)(up + 8 * g4 + 4); } if (WRITE) ring[k][2] = *(const f32x4*)(up + 4 * g4); }
    for (int ch0 = 0; ch0 < nch; ch0 += 2) {
#pragma unroll
      for (int k = 0; k < 2; ++k) {
        const int ch = ch0 + k, rr = r0 + 16 * ch;
        const f32x4 u0 = ring[k][0], u1 = ring[k][1], uv = ring[k][2];
        if (ch + 2 < nch) { const float* up = U + (size_t)(rr + 32 + fr) * 512 + g * 16; if (g4 < 2) { ring[k][0] = *(const f32x4*)(up + 8 * g4); ring[k][1] = *(const f32x4*)(up + 8 * g4 + 4); } if (WRITE) ring[k][2] = *(const f32x4*)(up + 4 * g4); }
        bf16x8 uf;
        { u32x4 w; w.x = pk2(u0[0], u0[1]); w.y = pk2(u0[2], u0[3]); w.z = pk2(u1[0], u1[1]); w.w = pk2(u1[2], u1[3]); uf = __builtin_bit_cast(bf16x8, w); }
#pragma unroll
        for (int nb = 0; nb < 8; ++nb) { const f32x4 c = __builtin_amdgcn_mfma_f32_16x16x32_bf16(F.bb[nb], uf, (f32x4){0.f, 0.f, 0.f, 0.f}, 0, 0, 0);
            *(LAS f32x4*)(bu + fr * S5_BU_STR + 16 * nb + 4 * g4) = c; }
        asm volatile("s_waitcnt lgkmcnt(0)" ::: "memory");
        f32x2 bvv[16];
#pragma unroll
        for (int t = 0; t < 16; ++t) bvv[t] = *(const LAS f32x2*)(bu + t * S5_BU_STR + 2 * lane);
#pragma unroll
        for (int t = 0; t < 16; ++t) {
            const float nre = __builtin_fmaf(F.ar, sre, __builtin_fmaf(-F.ai, sim, bvv[t][0])), nim = __builtin_fmaf(F.ar, sim, __builtin_fmaf(F.ai, sre, bvv[t][1])); sre = nre; sim = nim;
            if (WRITE) *(LAS unsigned*)((LAS unsigned char*)hs + t * (S5_HS_STR * 2) + 4 * lane) = pk2(sre, sim);
        }
        asm volatile("s_waitcnt lgkmcnt(0)" ::: "memory");
        if (WRITE) {
            f32x4 y = (f32x4){0.f, 0.f, 0.f, 0.f};
#pragma unroll
            for (int ks = 0; ks < 4; ++ks) { const bf16x8 hf = *(const LAS bf16x8*)((const LAS unsigned char*)hs + fr * (S5_HS_STR * 2) + ks * 64 + g4 * 16);
                y = __builtin_amdgcn_mfma_f32_16x16x32_bf16(F.cc[ks], hf, y, 0, 0, 0); }
            float o[4];
#pragma unroll
            for (int i = 0; i < 4; ++i) { const float v = y[i] + F.dsk[i] * uv[i]; const float z = 1.5957691216057308f * (v + 0.044715f * v * v * v); o[i] = v * frcp(1.0f + fexp2(-z * LOG2E)); }
            u32x2 w; w.x = pk2(o[0], o[1]); w.y = pk2(o[2], o[3]);
            *(LAS u32x2*)(wl + S5_YSTG + (16 * (ch & 7) + fr) * 32 + g4 * 8) = w;
            asm volatile("s_waitcnt lgkmcnt(0)" ::: "memory");
            if ((ch & 7) == 7 || ch == nch - 1) {
                const int nrow = 16 * ((ch & 7) + 1), rb = r0 + 16 * (ch & ~7);
                for (int i = 0; i < nrow; i += 16) { const u32x2 yv = *(const LAS u32x2*)(wl + S5_YSTG + (i + (lane >> 2)) * 32 + (lane & 3) * 8);
                    *(u32x2*)(YACT + (size_t)(rb + i + (lane >> 2)) * 512 + g * 16 + 4 * (lane & 3)) = yv; }
                asm volatile("s_waitcnt lgkmcnt(0)" ::: "memory");
            }
        }
      }
    }
}
__device__ __forceinline__ void s5_prompt_unit(const Args& a, LAS unsigned char* lds, int b, int g) {
    const int tid = threadIdx.x, lane = tid & 63, w = __builtin_amdgcn_readfirstlane(tid >> 6);
    S5Frags F; s5_load_frags(a, g, lane, F);
    LAS unsigned char* wl = lds + w * S5_WAVE_BYTES; LAS float* E = (LAS float*)(lds + 8 * S5_WAVE_BYTES);
    const int r0 = b * SEQ + 256 * w;
    float sre = 0.f, sim = 0.f;
    s5_run<false>(a, F, g, r0, 16, sre, sim, wl, lane);
    E[(w * 64 + lane) * 2] = sre; E[(w * 64 + lane) * 2 + 1] = sim;
    __syncthreads();
    float pr = F.ar, pi = F.ai;
#pragma unroll
    for (int i = 0; i < 8; ++i) { const float nr = pr * pr - pi * pi, ni = 2.f * pr * pi; pr = nr; pi = ni; }
    sre = 0.f; sim = 0.f;
    for (int j = 0; j < w; ++j) { const float er = E[(j * 64 + lane) * 2], ei = E[(j * 64 + lane) * 2 + 1]; const float nr = pr * sre - pi * sim + er, ni = pr * sim + pi * sre + ei; sre = nr; sim = ni; }
    s5_run<true>(a, F, g, r0, 16, sre, sim, wl, lane);
    if (w == 7) { a.out[O_REP + (size_t)(b * 32 + g) * 64 + lane] = sre; a.out[O_IMP + (size_t)(b * 32 + g) * 64 + lane] = sim; }
    __syncthreads();
}
__device__ __forceinline__ void s5_sample_unit(const Args& a, LAS unsigned char* lds, int unit) {
    const int tid = threadIdx.x, lane = tid & 63, w = __builtin_amdgcn_readfirstlane(tid >> 6);
    const int sidx = unit * 8 + w, b = sidx >> 5, g = sidx & 31;
    S5Frags F; s5_load_frags(a, g, lane, F);
    LAS unsigned char* wl = lds + w * S5_WAVE_BYTES;
    float sre = a.in[4][(size_t)(b * 32 + g) * 64 + lane], sim = a.in[5][(size_t)(b * 32 + g) * 64 + lane];
    s5_run<true>(a, F, g, MP + b * 64, 4, sre, sim, wl, lane);
    a.out[O_RES + (size_t)(b * 32 + g) * 64 + lane] = sre; a.out[O_IMS + (size_t)(b * 32 + g) * 64 + lane] = sim;
}


#define GAS __attribute__((address_space(1)))
#define XB_TMO      128
#define XB_XCNT(j)  (256  + 64 * (j))
#define XB_XSUB(j)  (1280 + 64 * (j))
#define XB_XGEN(j)  (2304 + 64 * (j))
#define XB_TOP      3328
#define XB_TOPGEN   3392
#define XCD_BAR_WORDS 3456
#define XB_SPIN_CAP (1u << 18)

__device__ __forceinline__ unsigned xb_ld(unsigned* p)              { return __hip_atomic_load(p, __ATOMIC_RELAXED, __HIP_MEMORY_SCOPE_AGENT); }
__device__ __forceinline__ unsigned xb_add(unsigned* p, unsigned v) { return __hip_atomic_fetch_add(p, v, __ATOMIC_RELAXED, __HIP_MEMORY_SCOPE_AGENT); }
__device__ __forceinline__ unsigned xb_xcc_id() { return (unsigned)__builtin_amdgcn_s_getreg((3 << 11) | 20) & 0xFu; }
#define XB_SPIN(cond, bar) do { unsigned _sp = 0; while (cond) { __builtin_amdgcn_s_sleep(1); \
    if ((++_sp & 255u) == 0u) { if (xb_ld(&(bar)[XB_TMO])) break; if (_sp > XB_SPIN_CAP) { atomicAdd(&(bar)[XB_TMO], 1u); break; } } } } while (0)

struct XcdBarrier {
    unsigned* bar; unsigned x;
    volatile LAS unsigned* st;
};

__device__ __forceinline__ XcdBarrier xcd_barrier_post(unsigned* bar, volatile LAS unsigned* st) {
    XcdBarrier b; b.bar = bar; b.x = xb_xcc_id(); b.st = st;
    if (threadIdx.x == 0) (void)xb_add(&bar[XB_XCNT(b.x)], 1u);
    return b;
}
__device__ __forceinline__ void xcd_barrier_complete(unsigned* bar, unsigned x, unsigned& nloc, unsigned& nx) {
    const unsigned G = gridDim.x * gridDim.y * gridDim.z;
    unsigned sum, cnt, mine, sp = 0u;
    for (;;) {
        sum = 0u; cnt = 0u; mine = 0u;
#pragma unroll
        for (unsigned j = 0; j < 16; ++j) { const unsigned c = xb_ld(&bar[XB_XCNT(j)]); sum += c; cnt += (c > 0u) ? 1u : 0u; mine = (j == x) ? c : mine; }
        if (sum == G) break;
        __builtin_amdgcn_s_sleep(1);
        if ((++sp & 255u) == 0u) { if (xb_ld(&bar[XB_TMO])) break; if (sp > XB_SPIN_CAP) { atomicAdd(&bar[XB_TMO], 1u); break; } }
    }
    nloc = mine > 0u ? mine : 1u; nx = cnt > 0u ? cnt : 1u;
}

__device__ __forceinline__ void xcd_barrier(const XcdBarrier& b) {
    asm volatile("s_waitcnt vmcnt(0)" ::: "memory");
    __syncthreads();
    if (threadIdx.x == 0) {
        unsigned* bar = b.bar;
        __builtin_amdgcn_s_waitcnt(0);
        unsigned nloc = b.st[0], nx = b.st[1];
        if (nloc == 0u) { xcd_barrier_complete(bar, b.x, nloc, nx); b.st[0] = nloc; b.st[1] = nx; }
        const unsigned old = xb_add(&bar[XB_XSUB(b.x)], 1u);
        const unsigned gen = old / nloc;
        if (old + 1u == (gen + 1u) * nloc) {
            __builtin_amdgcn_fence(__ATOMIC_RELEASE, "agent");
            asm volatile("s_waitcnt vmcnt(0)" ::: "memory");
            const unsigned og = xb_add(&bar[XB_TOP], 1u);
            const unsigned tg = og / nx;
            if (og + 1u == (tg + 1u) * nx) xb_add(&bar[XB_TOPGEN], 1u);
            else XB_SPIN(xb_ld(&bar[XB_TOPGEN]) == tg, bar);
            __builtin_amdgcn_fence(__ATOMIC_ACQUIRE, "agent");
            xb_add(&bar[XB_XGEN(b.x)], 1u);
            asm volatile("s_waitcnt vmcnt(0)" ::: "memory");
        } else {
            XB_SPIN(xb_ld(&bar[XB_XGEN(b.x)]) == gen, bar);
            __builtin_amdgcn_fence(__ATOMIC_ACQUIRE, "agent");
            asm volatile("s_waitcnt vmcnt(0)" ::: "memory");
        }
    }
    __syncthreads();
}

constexpr int CV_GU = 16 * 176, CV_D = 44 * 32, CV_IN = 16 * 64, CV_GLU = 8 * 16, CV_SQ = 16 * 32;
constexpr int CV_NA = CV_GU + CV_D + CV_IN + CV_GLU + 3 * CV_SQ, CV_NB = CV_GU + CV_D + 2 * CV_SQ;
__device__ __forceinline__ void conv_item(const Args& a, int it, LAS float* scr, int lane) {
    unsigned char* ws = a.ws; int r = it;
    if (r < CV_GU) { tr_item(a.in[10], 1024, 5632, (bf16_t*)(ws + W_GU1), a.in[9], 1, 0, scr, r, lane); return; } r -= CV_GU;
    if (r < CV_D) { tr_item(a.in[11], 2816, 1024, (bf16_t*)(ws + W_D1), nullptr, 0, 0, scr, r, lane); return; } r -= CV_D;
    if (r < CV_IN) { tr_item(a.in[13], 1024, 2048, (bf16_t*)(ws + W_IN), a.in[12], 0, 0, scr, r, lane); return; } r -= CV_IN;
    if (r < CV_GLU) { tr_item(a.in[22], 512, 512, (bf16_t*)(ws + W_GLU), nullptr, 0, 0, scr, r, lane); return; } r -= CV_GLU;
    if (r < CV_SQ) { tr_item(a.in[27], 1024, 1024, (bf16_t*)(ws + W_OUT), nullptr, 0, 0, scr, r, lane); return; } r -= CV_SQ;
    if (r < CV_SQ) { tr_item(a.in[31], 1024, 1024, (bf16_t*)(ws + W_CKV), a.in[28], 0, 0, scr, r, lane); return; } r -= CV_SQ;
    if (r < CV_SQ) { tr_item(a.in[32], 1024, 1024, (bf16_t*)(ws + W_CKV), a.in[28], 0, 1024, scr, r, lane); return; } r -= CV_SQ;
    if (r < CV_GU) { tr_item(a.in[35], 1024, 5632, (bf16_t*)(ws + W_GU2), a.in[34], 1, 0, scr, r, lane); return; } r -= CV_GU;
    if (r < CV_D) { tr_item(a.in[36], 2816, 1024, (bf16_t*)(ws + W_D2), nullptr, 0, 0, scr, r, lane); return; } r -= CV_D;
    if (r < CV_SQ) { tr_item(a.in[30], 1024, 1024, (bf16_t*)(ws + W_CQ), a.in[29], 0, 0, scr, r, lane); return; } r -= CV_SQ;
    tr_item(a.in[33], 1024, 1024, (bf16_t*)(ws + W_CO), nullptr, 0, 0, scr, r, lane);
}

#ifndef NPH
#define NPH 13
#endif
__global__ void __launch_bounds__(512, 2) mega_fwd(Args a) {
    extern __shared__ __attribute__((aligned(16))) unsigned char lds_raw[];
    LAS unsigned char* lds = (LAS unsigned char*)lds_raw;
    cg::grid_group grid = cg::this_grid();
    const int tid = threadIdx.x, lane = tid & 63, wave = __builtin_amdgcn_readfirstlane(tid >> 6);
    const int G = gridDim.x, c = blockIdx.x;
    const int gw = c * 8 + wave, NGW = G * 8;
    unsigned char* ws = a.ws;
    float* SS = (float*)(ws + W_SSP);
    float* ss1 = SS, *ss2 = SS + (size_t)MT * 16, *ss3 = SS + (size_t)2 * MT * 16, *ss4 = SS + (size_t)3 * MT * 16, *ss5 = SS + (size_t)4 * MT * 16, *ssm = SS + (size_t)5 * MT * 16;
    bf16_t* RB = (bf16_t*)(ws + W_RB); float* R = (float*)(ws + W_R); bf16_t* H = (bf16_t*)(ws + W_H);
#define IN(k) (a.lo <= (k) && (k) < a.hi)
#define SEAM(k) do { if (IN(k) && IN((k) + 1)) xcd_barrier(bar); } while (0)

    volatile LAS unsigned* MISC = (volatile LAS unsigned*)(lds + 147440);
    if (tid < 2) MISC[tid] = 0u;
    __syncthreads();
    XcdBarrier bar = xcd_barrier_post((unsigned*)(ws + W_BAR), MISC);
    if (a.hi < 0) grid.sync();
    if (IN(0)) {
        LAS float* scr = (LAS float*)(lds + wave * 16384);
        const int itEnd = (G == 256) ? CV_NA : CV_NA + CV_NB;
        for (int it = gw; it < itEnd; it += NGW) conv_item(a, it, scr, lane);
        constexpr int NROWS = MT + 2048 + 4096 + 4096;
        for (int r2 = gw; r2 < NROWS / 2; r2 += NGW) {
            const float* src[2]; bf16_t* dst[2]; float* sso[2];
#pragma unroll
            for (int e = 0; e < 2; ++e) { const int r = 2 * r2 + e;
                if (r < MP) { src[e] = a.in[0] + (size_t)r * DM; dst[e] = RB + (size_t)r * DM; sso[e] = ss1 + (size_t)r * 16; }
                else if (r < MT) { src[e] = a.in[1] + (size_t)(r - MP) * DM; dst[e] = RB + (size_t)r * DM; sso[e] = ss1 + (size_t)r * 16; }
                else if (r < MT + 2048) { src[e] = a.in[8] + (size_t)(r - MT) * DM; dst[e] = (bf16_t*)(ws + W_MEMB) + (size_t)(r - MT) * DM; sso[e] = ssm + (size_t)(r - MT) * 16; }
                else if (r < MT + 2048 + 4096) { src[e] = a.in[6] + (size_t)(r - MT - 2048) * DM; dst[e] = (bf16_t*)(ws + W_MK) + (size_t)(r - MT) * DM; sso[e] = nullptr; }
                else { src[e] = a.in[7] + (size_t)(r - MT - 6144) * DM; dst[e] = (bf16_t*)(ws + W_MV) + (size_t)(r - MT - 4096) * DM; sso[e] = nullptr; } }
            f32x4 v[2][4];
#pragma unroll
            for (int e = 0; e < 2; ++e)
#pragma unroll
                for (int j = 0; j < 4; ++j) v[e][j] = ((const f32x4*)src[e] + lane)[64 * j];
#pragma unroll
            for (int e = 0; e < 2; ++e) { float sq = 0.f; const bool isx = (2 * r2 + e) < MT;
#pragma unroll
                for (int j = 0; j < 4; ++j) sq += (v[e][j][0] * v[e][j][0] + v[e][j][1] * v[e][j][1]) + (v[e][j][2] * v[e][j][2] + v[e][j][3] * v[e][j][3]);
                float sc = 1.0f;
                if (sso[e]) { sq = wave_sum(sq); if (lane < 16) sso[e][lane] = lane == 0 ? sq : 0.f; if (isx) sc = rstd_of(sq); }
#pragma unroll
                for (int j = 0; j < 4; ++j) { u32x2 w; w.x = pk2(v[e][j][0] * sc, v[e][j][1] * sc); w.y = pk2(v[e][j][2] * sc, v[e][j][3] * sc); ((u32x2*)dst[e] + lane)[64 * j] = w; } }
        }
        { const int gp = c * 512 + tid;
          if (gp < 2048) { const int g = gp >> 6;
            const float dt = expf(a.in[16][g]), lr = a.in[14][gp], li = a.in[15][gp];
            const float x = lr * dt, y = li * dt, er = expf(x), cy = cosf(y), sy = sinf(y), sh = sinf(0.5f * y);
            const float ar = er * cy, ai = er * sy;
            const float nr = expm1f(x) * cy - 2.f * sh * sh, ni = ai;
            const float den = lr * lr + li * li, fre = (nr * lr + ni * li) / den, fim = (ni * lr - nr * li) / den;
            float* ABAR = (float*)(ws + W_ABAR); float* BBAR = (float*)(ws + W_BBAR);
            ABAR[gp * 2] = ar; ABAR[gp * 2 + 1] = ai;
            const int p = gp & 63;
            for (int h = 0; h < 16; ++h) { const float br = a.in[17][(size_t)gp * 16 + h], bi = a.in[18][(size_t)gp * 16 + h];
                BBAR[((size_t)((g * 2 + 0) * 64 + p)) * 16 + h] = fre * br - fim * bi; BBAR[((size_t)((g * 2 + 1) * 64 + p)) * 16 + h] = fre * bi + fim * br; }
          } }
        if (c == 0 && tid == 0) { float s0 = 0.f, s1 = 0.f; for (int i = 0; i < 64; ++i) { s0 += a.in[24][i] * a.in[25][i]; s1 += a.in[24][64 + i] * a.in[25][64 + i]; }
            *(float*)(ws + W_LAM) = expf(s0) - expf(s1) + LAM_INIT; }
    }
    SEAM(0);
    if (IN(1)) {
        pg8::Gemm g{RB, (const bf16_t*)(ws + W_GU1), MT, 5632, 1024}; pg8::StaticOrder S; S.init(MT, 5632, G, c);
        EpiSwiglu<0> E{nullptr, H};
        pg8::gemm_phase<EpiSwiglu<0>, pg8::StaticOrder, true, true>(lds, g, S, E);
    }
    SEAM(1);
    if (IN(2)) {
        pg8::Gemm g{H, (const bf16_t*)(ws + W_D1), MP, 1024, 2816}; pg8::StaticOrder S; S.init(MP, 1024, G, c);
        EpiResid2 E{EpiResid{a.in[0], nullptr, RB, ss2, 0.5f}, EpiResid{a.in[1] - (size_t)MP * DM, nullptr, RB, ss2, 0.5f}};
        pg8::gemm_phase<EpiResid2, pg8::StaticOrder, true, true>(lds, g, S, E);
        for (int u = c; u < 256; u += G) mini_gemm(lds, H, (const bf16_t*)(ws + W_D1), 2816, MP + 64 * (u >> 4), 64 * (u & 15), E.s);
    }
    SEAM(2);
    if (IN(3)) {
        { pg8::Gemm g{RB, (const bf16_t*)(ws + W_IN), MP, 2048, 1024}; pg8::StaticOrder S; S.init(MP, 2048, G, c);
          LAS float* rl = (LAS float*)(lds + 131072);
          { pg8::Unit uu; for (int i = 0; i < 16 && S.next(i, uu); ++i) if (tid < 256) rl[256 * i + tid] = rstd_row(ss2, uu.pm * 256 + tid); }
          __syncthreads();
          EpiInproj E{ss2, (float*)(ws + W_U), (bf16_t*)(ws + W_QB), (bf16_t*)(ws + W_KB), (bf16_t*)(ws + W_VB), a.out, rl};
          pg8::gemm_phase<EpiInproj, pg8::StaticOrder, true, true>(lds, g, S, E);
          for (int u = c; u < 512; u += G) mini_gemm(lds, RB, (const bf16_t*)(ws + W_IN), 1024, MP + 64 * (u >> 5), 64 * (u & 31), E); }
    }
    SEAM(3);
    if (IN(4)) {
        const bool sample_first = ((c >> 3) & 1) == 0;
        if (sample_first) for (int sid = c; sid < 256; sid += G) { const int bh = sid >> 2; diff_sample_unit(a, lds, bh >> 2, bh & 3, sid & 3); }
        for (int u = c; u < 256; u += G) s5_prompt_unit(a, lds, u >> 5, u & 31);
        for (int u = c; u < 256; u += G) if ((u & 3) == 0) s5_sample_unit(a, lds, u >> 2);
        __syncthreads();
        const float lam = *(const float*)(ws + W_LAM);
        if (G == 256) {
            const int j = c >> 3, bh = 4 * (c & 7) + (j >> 3), cp = j & 7;
            diff_prompt_unit(a, lds, bh >> 2, bh & 3, 15 - cp, lam); diff_prompt_unit(a, lds, bh >> 2, bh & 3, cp, lam);
        } else
        for (int pid = c; pid < 256; pid += G) { const int bh = pid >> 3, cp = pid & 7;
            diff_prompt_unit(a, lds, bh >> 2, bh & 3, 15 - cp, lam); diff_prompt_unit(a, lds, bh >> 2, bh & 3, cp, lam); }
        if (!sample_first) for (int sid = c; sid < 256; sid += G) { const int bh = sid >> 2; diff_sample_unit(a, lds, bh >> 2, bh & 3, sid & 3); }
    }
    SEAM(4);
    if (IN(5)) {
        const float lam = *(const float*)(ws + W_LAM);
        const float* P = (const float*)(ws + W_PART); const float* ML = (const float*)(ws + W_ML); bf16_t* CAT = (bf16_t*)(ws + W_CAT);
        for (int idx = gw; idx < 4096; idx += NGW) {
            const int bh = idx >> 6, q = idx & 63; float on[2][2];
#pragma unroll
            for (int map = 0; map < 2; ++map) {
                float mm[4], ll[4]; float M = -INFINITY;
#pragma unroll
                for (int sp = 0; sp < 4; ++sp) { const int pi = ((bh * 4 + sp) * 2 + map) * 64 + q; mm[sp] = ML[pi * 2]; ll[sp] = ML[pi * 2 + 1]; M = __builtin_fmaxf(M, mm[sp]); }
                float Lt = 0.f, o0 = 0.f, o1 = 0.f;
#pragma unroll
                for (int sp = 0; sp < 4; ++sp) { const int pi = ((bh * 4 + sp) * 2 + map) * 64 + q; const float wgt = fexp2(mm[sp] - M); Lt += wgt * ll[sp];
                    const f32x2 pv = *(const f32x2*)(P + (size_t)pi * 128 + 2 * lane); o0 += wgt * pv[0]; o1 += wgt * pv[1]; }
                on[map][0] = o0 / Lt; on[map][1] = o1 / Lt;
            }
            const float d0 = on[0][0] - lam * on[1][0], d1 = on[0][1] - lam * on[1][1];
            const float ss = wave_sum(d0 * d0 + d1 * d1); const float rn = (1.0f - LAM_INIT) / sqrtf(ss * (1.0f / 128.0f) + EPS);
            const int b = bh >> 2, h = bh & 3;
            *(unsigned*)(CAT + (size_t)(MP + b * 64 + q) * DM + 512 + h * 128 + 2 * lane) = pk2(d0 * rn * a.in[26][2 * lane], d1 * rn * a.in[26][2 * lane + 1]);
        }
        pg8::Gemm g{(const bf16_t*)(ws + W_YACT), (const bf16_t*)(ws + W_GLU), MT, 512, 512}; pg8::StaticOrder S; S.init(MT, 512, G, c);
        EpiGlu E{(const bf16_t*)(ws + W_YACT), a.in[23], CAT};
        pg8::gemm_phase<EpiGlu, pg8::StaticOrder, true, true>(lds, g, S, E);
        { pg8::Gemm g2{(const bf16_t*)(ws + W_MEMB), (const bf16_t*)(ws + W_CKV), 2048, 2048, 1024}; pg8::StaticOrder S2; S2.init(2048, 2048, G, (c + G - 136) % G);
          EpiMem E2{ssm, a.out, (bf16_t*)(ws + W_MK), (bf16_t*)(ws + W_MV)};
          pg8::gemm_phase<EpiMem, pg8::StaticOrder, true, true>(lds, g2, S2, E2); }
        if (G == 256 && (c < 136 || c >= 200)) {
            LAS float* scr = (LAS float*)(lds + wave * 16384);
            const int wv = (c < 136 ? c : c - 64) * 8 + wave;
            for (int it = CV_NA + wv; it < CV_NA + CV_NB; it += 192 * 8) conv_item(a, it, scr, lane);
        }
    }
    SEAM(5);
    if (IN(6)) {
        pg8::Gemm g{(const bf16_t*)(ws + W_CAT), (const bf16_t*)(ws + W_OUT), MP, 1024, 1024}; pg8::StaticOrder S; S.init(MP, 1024, G, c);
        EpiResid E{nullptr, RB, RB, ss3, 1.0f};
        pg8::gemm_phase<EpiResid, pg8::StaticOrder, true, true>(lds, g, S, E);
        for (int u = c; u < 256; u += G) mini_gemm(lds, (const bf16_t*)(ws + W_CAT), (const bf16_t*)(ws + W_OUT), 1024, MP + 64 * (u >> 4), 64 * (u & 15), E);
    }
    SEAM(6);
    if (IN(7)) {
        pg8::Gemm g{RB, (const bf16_t*)(ws + W_CQ), MP, 1024, 1024}; pg8::StaticOrder S; S.init(MP, 1024, G, c);
        EpiScaleBf16 E{ss3, (bf16_t*)(ws + W_QC), QS_CROSS};
        pg8::gemm_phase<EpiScaleBf16, pg8::StaticOrder, true, true>(lds, g, S, E);
        for (int u = c; u < 256; u += G) mini_gemm(lds, RB, (const bf16_t*)(ws + W_CQ), 1024, MP + 64 * (u >> 4), 64 * (u & 15), E);
    }
    SEAM(7);
    if (IN(8)) {
        if (G == 256) {
            for (int i = 0; i < 2; ++i) { const int item = (c >> 3) + 32 * i, bh = 4 * (c & 7) + (item >> 4); cross_unit(a, lds, bh >> 2, bh & 3, item & 15); }
            if (c < 64) cross_unit(a, lds, 8 + (c >> 2), c & 3, 0);
        } else
        for (int u = c; u < 576; u += G) {
            if (u < 512) cross_unit(a, lds, u >> 6, (u >> 4) & 3, u & 15);
            else { const int v = u - 512; cross_unit(a, lds, 8 + (v >> 2), v & 3, 0); }
        }
    }
    SEAM(8);
    if (IN(9)) {
        pg8::Gemm g{(const bf16_t*)(ws + W_OC), (const bf16_t*)(ws + W_CO), MP, 1024, 1024}; pg8::StaticOrder S; S.init(MP, 1024, G, c);
        EpiResid E{nullptr, RB, RB, ss4, 1.0f};
        pg8::gemm_phase<EpiResid, pg8::StaticOrder, true, true>(lds, g, S, E);
        for (int u = c; u < 256; u += G) mini_gemm(lds, (const bf16_t*)(ws + W_OC), (const bf16_t*)(ws + W_CO), 1024, MP + 64 * (u >> 4), 64 * (u & 15), E);
    }
    SEAM(9);
    if (IN(10)) {
        pg8::Gemm g{RB, (const bf16_t*)(ws + W_GU2), MT, 5632, 1024}; pg8::StaticOrder S; S.init(MT, 5632, G, c);
        LAS float* rl = (LAS float*)(lds + 131072);
        { pg8::Unit uu; for (int i = 0; i < 16 && S.next(i, uu); ++i) if (tid < 256) rl[256 * i + tid] = rstd_row(ss4, uu.pm * 256 + tid); }
        __syncthreads();
        EpiSwiglu<2> E{rl, H};
        pg8::gemm_phase<EpiSwiglu<2>, pg8::StaticOrder, true, true>(lds, g, S, E);
    }
    SEAM(10);
    if (IN(11)) {
        pg8::Gemm g{H, (const bf16_t*)(ws + W_D2), MP, 1024, 2816}; pg8::StaticOrder S; S.init(MP, 1024, G, c);
        EpiResid E{nullptr, RB, RB, ss5, 0.5f};
        pg8::gemm_phase<EpiResid, pg8::StaticOrder, true, true>(lds, g, S, E);
        for (int u = c; u < 256; u += G) mini_gemm(lds, H, (const bf16_t*)(ws + W_D2), 2816, MP + 64 * (u >> 4), 64 * (u & 15), E);
    }
    SEAM(11);
    if (IN(12)) {
#pragma unroll 2
        for (int r = gw; r < MT; r += NGW) {
            const float rs = rstd_row(ss5, r); const u32x4* xr = (const u32x4*)(RB + (size_t)r * DM) + lane; const f32x4* gr = (const f32x4*)a.in[37]; f32x4* o = (f32x4*)(a.out + O_Y + (size_t)r * DM);
#pragma unroll
            for (int j = 0; j < 2; ++j) { const u32x4 t = xr[64 * j]; const int c8 = (64 * j + lane) * 2;
                const f32x4 x0 = (f32x4){__builtin_bit_cast(float, t.x << 16), __builtin_bit_cast(float, t.x & 0xffff0000u), __builtin_bit_cast(float, t.y << 16), __builtin_bit_cast(float, t.y & 0xffff0000u)};
                const f32x4 x1 = (f32x4){__builtin_bit_cast(float, t.z << 16), __builtin_bit_cast(float, t.z & 0xffff0000u), __builtin_bit_cast(float, t.w << 16), __builtin_bit_cast(float, t.w & 0xffff0000u)};
                o[c8] = x0 * gr[c8] * rs; o[c8 + 1] = x1 * gr[c8 + 1] * rs; }
        }
    }
#undef IN
#undef SEAM
}

extern "C" void kernel_launch(void* const* d_in, const int* in_sizes, int n_in, void* d_out, int out_size, void* d_ws, size_t ws_size, hipStream_t stream) {
    static int grid = 0;
    if (grid == 0) {
        if (n_in != 38 || (size_t)out_size != O_TOTAL || ws_size < W_END) { fprintf(stderr, "kernel_launch: unexpected shapes: n_in %d out %d ws %zu\n", n_in, out_size, ws_size); grid = -1; return; }
        int dev = 0, cus = 0, per_cu = 0;
        (void)hipGetDevice(&dev); (void)hipDeviceGetAttribute(&cus, hipDeviceAttributeMultiprocessorCount, dev);
        (void)hipFuncSetAttribute((const void*)mega_fwd, hipFuncAttributeMaxDynamicSharedMemorySize, LDS_BYTES);
        (void)hipOccupancyMaxActiveBlocksPerMultiprocessor(&per_cu, (const void*)mega_fwd, 512, LDS_BYTES);
        (void)hipGetLastError();
        if (per_cu < 1) fprintf(stderr, "kernel_launch: occupancy query says %d blocks per CU\n", per_cu);
        grid = cus > 0 ? cus : 256;
    }
    if (grid < 0) return;
    (void)hipMemsetAsync((char*)d_ws + W_BAR, 0, 16384, stream);
    Args a{};
    for (int i = 0; i < 38; ++i) a.in[i] = (const float*)d_in[i];
    a.out = (float*)d_out; a.ws = (unsigned char*)d_ws; a.lo = 0; a.hi = NPH;
    void* args[] = {&a};
    hipError_t e = hipLaunchCooperativeKernel((const void*)mega_fwd, dim3(grid), dim3(512), args, LDS_BYTES, stream);
    if (e != hipSuccess) fprintf(stderr, "cooperative launch failed: %s (grid %d)\n", hipGetErrorString(e), grid);
}
```
